# Optimizing an MI355X kernel written in HIP

```python
import jax, jax.numpy as jnp
from jax import lax
import numpy as np

D_MODEL = 2048
BATCH = 4
SEQ = 4096
DEPTH = 1

HEAD_DIM = 128
ROPE_THETA = 10000.0
BLOCK = 128
A_PATTERNS = ((128, 1), (512, 4), (2048, 16))
A_HEADS_PER_GROUP = 4
A_GROUPS = len(A_PATTERNS)
A_HEADS = A_HEADS_PER_GROUP * A_GROUPS
A_QKV = A_HEADS * HEAD_DIM
A_OUT = A_HEADS_PER_GROUP * HEAD_DIM
B_Q_HEADS = 8
B_KV_HEADS = 2
B_GROUP = B_Q_HEADS // B_KV_HEADS
B_WINDOW = 128
B_Q = B_Q_HEADS * HEAD_DIM
B_KV = B_KV_HEADS * HEAD_DIM
IN_COLS = 3 * A_QKV + B_Q + 2 * B_KV + 2 * D_MODEL
PEER_HEADS = 8
PEER_QDIM = 256
PEER_HALF = PEER_QDIM // 2
N_KEYS = 128
N_EXPERTS = N_KEYS * N_KEYS
PEER_TOPK = 16
PEER_CHUNK = 128
PLE_DIM = 256
LN_EPS = 1e-5
DN_ALPHA = (2 * DEPTH) ** 0.25
DN_BETA = (8 * DEPTH) ** -0.25

kernel_name = "hybrid_dilated_swa_peer_deepnorm"


def layer_norm(x, g, b):
    xf = x.astype(jnp.float32)
    mu = jnp.mean(xf, axis=-1, keepdims=True)
    var = jnp.mean(jnp.square(xf - mu), axis=-1, keepdims=True)
    return ((xf - mu) * lax.rsqrt(var + LN_EPS) * g.astype(jnp.float32) + b.astype(jnp.float32)).astype(x.dtype)


def rope_tables(seq):
    inv = 1.0 / (ROPE_THETA ** (jnp.arange(0, HEAD_DIM, 2, dtype=jnp.float32) / HEAD_DIM))
    ang = jnp.arange(seq, dtype=jnp.float32)[:, None] * inv[None, :]
    return jnp.cos(ang), jnp.sin(ang)


def apply_rope(t, cos, sin):
    t1, t2 = jnp.split(t.astype(jnp.float32), 2, axis=-1)
    c = cos[:, None, :]
    s = sin[:, None, :]
    return jnp.concatenate([t1 * c - t2 * s, t1 * s + t2 * c], axis=-1).astype(t.dtype)


def banded_causal_attention(q, k, v, max_dist, sink=None):
    L, hd = q.shape[-2], q.shape[-1]
    nb = -(-L // BLOCK)
    pad = nb * BLOCK - L
    if pad:
        q = jnp.pad(q, [(0, 0)] * (q.ndim - 2) + [(0, pad), (0, 0)])
        k = jnp.pad(k, [(0, 0)] * (k.ndim - 2) + [(0, pad), (0, 0)])
        v = jnp.pad(v, [(0, 0)] * (v.ndim - 2) + [(0, pad), (0, 0)])
    lead = k.shape[:-2]
    qb = q.reshape(*q.shape[:-2], nb, BLOCK, hd)

    def band(t):
        tb = t.reshape(*lead, nb, BLOCK, hd)
        prev = jnp.concatenate([jnp.zeros_like(tb[..., :1, :, :]), tb[..., :-1, :, :]], axis=-3)
        return jnp.concatenate([prev, tb], axis=-2)

    kb, vb = band(k), band(v)
    s = jnp.einsum('...gnqd,...nkd->...gnqk', qb, kb,
                   preferred_element_type=jnp.float32) * (hd ** -0.5)
    qpos = jnp.arange(nb)[:, None, None] * BLOCK + jnp.arange(BLOCK)[None, :, None]
    kpos = jnp.arange(nb)[:, None, None] * BLOCK - BLOCK + jnp.arange(2 * BLOCK)[None, None, :]
    dist = qpos - kpos
    mask = (dist >= 0) & (dist <= max_dist) & (kpos >= 0)
    s = jnp.where(mask, s, -jnp.inf)
    m = jnp.max(s, axis=-1)
    if sink is not None:
        m = jnp.maximum(m, sink)
    pr = jnp.exp(s - m[..., None])
    l = jnp.sum(pr, axis=-1)
    denom = l + jnp.exp(sink - m) if sink is not None else l
    o = jnp.einsum('...gnqk,...nkd->...gnqd', pr, vb.astype(jnp.float32)) / denom[..., None]
    o = o.reshape(*o.shape[:-3], nb * BLOCK, hd)[..., :L, :]
    m = m.reshape(*m.shape[:-2], nb * BLOCK)[..., :L]
    l = l.reshape(*l.shape[:-2], nb * BLOCK)[..., :L]
    return o, m, l


def dilated_group_attention(q, k, v, window, dil):
    Bn, H, S, hd = q.shape
    L = S // dil

    def gather(t):
        return t.reshape(Bn, H, L, dil, hd).transpose(0, 1, 3, 2, 4)

    o, m, l = banded_causal_attention(gather(q)[..., None, :, :], gather(k), gather(v), window // dil)
    o = o[..., 0, :, :].transpose(0, 1, 3, 2, 4).reshape(Bn, H, S, hd)
    m = m[..., 0, :].transpose(0, 1, 3, 2).reshape(Bn, H, S)
    l = l[..., 0, :].transpose(0, 1, 3, 2).reshape(Bn, H, S)
    return o, m, l


def hybrid_mixer(h, cos, sin, w_in, sinks, w_branch_a, w_branch_b, w_out):
    Bn, S, _ = h.shape
    z = h @ w_in
    cuts = [int(c) for c in np.cumsum([A_QKV, A_QKV, A_QKV, B_Q, B_KV, B_KV, D_MODEL])]
    qa, ka, va, qb, kb, vb, ga, gb = jnp.split(z, cuts, axis=-1)

    def heads_a(t):
        t = t.reshape(Bn, S, A_GROUPS, A_HEADS_PER_GROUP, HEAD_DIM)
        return t.transpose(2, 0, 3, 1, 4)
    qa = heads_a(apply_rope(qa.reshape(Bn, S, A_HEADS, HEAD_DIM), cos, sin))
    ka = heads_a(apply_rope(ka.reshape(Bn, S, A_HEADS, HEAD_DIM), cos, sin))
    va = heads_a(va)
    os_, ms_, ls_ = [], [], []
    for g, (window, dil) in enumerate(A_PATTERNS):
        o, m, l = dilated_group_attention(qa[g], ka[g], va[g], window, dil)
        os_.append(o)
        ms_.append(m)
        ls_.append(l)
    os_, ms_, ls_ = jnp.stack(os_), jnp.stack(ms_), jnp.stack(ls_)
    wts = ls_ * jnp.exp(ms_ - jnp.max(ms_, axis=0, keepdims=True))
    o_a = jnp.sum(wts[..., None] * os_, axis=0) / jnp.sum(wts, axis=0)[..., None]
    o_a = o_a.transpose(0, 2, 1, 3).reshape(Bn, S, A_OUT).astype(h.dtype)

    qb = apply_rope(qb.reshape(Bn, S, B_Q_HEADS, HEAD_DIM), cos, sin)
    qb = qb.reshape(Bn, S, B_KV_HEADS, B_GROUP, HEAD_DIM).transpose(0, 2, 3, 1, 4)
    kb = apply_rope(kb.reshape(Bn, S, B_KV_HEADS, HEAD_DIM), cos, sin).transpose(0, 2, 1, 3)
    vb = vb.reshape(Bn, S, B_KV_HEADS, HEAD_DIM).transpose(0, 2, 1, 3)
    sink = sinks.astype(jnp.float32).reshape(B_KV_HEADS, B_GROUP, 1, 1)
    o_b, _, _ = banded_causal_attention(qb, kb, vb, B_WINDOW - 1, sink)
    o_b = o_b.transpose(0, 3, 1, 2, 4).reshape(Bn, S, B_Q).astype(h.dtype)

    merged = jax.nn.sigmoid(ga) * (o_a @ w_branch_a) + jax.nn.sigmoid(gb) * (o_b @ w_branch_b)
    return merged @ w_out


def peer_ffn(h, wq, subkeys, u_tab, v_tab):
    Bn, S, D = h.shape
    T = Bn * S
    xt = h.reshape(T, D)
    q = (xt @ wq).reshape(T, PEER_HEADS, 2, PEER_HALF)
    s = jnp.einsum('thcd,hcnd->thcn', q, subkeys, preferred_element_type=jnp.float32)
    top_s, top_i = lax.top_k(s, PEER_TOPK)
    cand = top_s[:, :, 0, :, None] + top_s[:, :, 1, None, :]
    best_s, best_c = lax.top_k(cand.reshape(T, PEER_HEADS, PEER_TOPK * PEER_TOPK), PEER_TOPK)
    i1 = jnp.take_along_axis(top_i[:, :, 0], best_c // PEER_TOPK, axis=-1)
    i2 = jnp.take_along_axis(top_i[:, :, 1], best_c % PEER_TOPK, axis=-1)
    expert = i1 * N_KEYS + i2
    gate = jax.nn.softmax(best_s, axis=-1)
    nc = T // PEER_CHUNK

    def chunk(args):
        xc, ec, gc = args
        u = u_tab[ec]
        act = jax.nn.gelu(jnp.einsum('cd,chkd->chk', xc, u, preferred_element_type=jnp.float32),
                          approximate=False)
        w = (gc * act).astype(v_tab.dtype)
        return jnp.einsum('chk,chkd->cd', w, v_tab[ec])

    out = lax.map(chunk, (xt.reshape(nc, PEER_CHUNK, D),
                          expert.reshape(nc, PEER_CHUNK, PEER_HEADS, PEER_TOPK),
                          gate.reshape(nc, PEER_CHUNK, PEER_HEADS, PEER_TOPK)))
    return out.reshape(Bn, S, D).astype(h.dtype)


def setup_inputs(seed: int = 0) -> dict:
    key = jax.random.key(seed)
    ks = jax.random.split(key, 18)
    f = jnp.float32

    def nrm(k, shape, scale):
        return jax.random.normal(k, shape, f) * scale

    return {
        "x": nrm(ks[0], (BATCH, SEQ, D_MODEL), 1.0),
        "p": nrm(ks[1], (DEPTH, BATCH, SEQ, PLE_DIM), 1.0),
        "w_in": nrm(ks[2], (DEPTH, D_MODEL, IN_COLS), D_MODEL ** -0.5),
        "sinks": nrm(ks[3], (DEPTH, B_Q_HEADS), 0.5),
        "w_branch_a": nrm(ks[4], (DEPTH, A_OUT, D_MODEL), A_OUT ** -0.5),
        "w_branch_b": nrm(ks[5], (DEPTH, B_Q, D_MODEL), B_Q ** -0.5),
        "w_out": nrm(ks[6], (DEPTH, D_MODEL, D_MODEL), DN_BETA * D_MODEL ** -0.5),
        "ln1_g": 1.0 + nrm(ks[7], (DEPTH, D_MODEL), 0.02),
        "ln1_b": nrm(ks[8], (DEPTH, D_MODEL), 0.02),
        "peer_wq": nrm(ks[9], (DEPTH, D_MODEL, PEER_HEADS * PEER_QDIM), D_MODEL ** -0.5),
        "peer_subkeys": nrm(ks[10], (DEPTH, PEER_HEADS, 2, N_KEYS, PEER_HALF), PEER_HALF ** -0.5),
        "peer_u": nrm(ks[11], (DEPTH, N_EXPERTS, D_MODEL), D_MODEL ** -0.5),
        "peer_v": nrm(ks[12], (DEPTH, N_EXPERTS, D_MODEL), DN_BETA * PEER_HEADS ** -0.5),
        "ple_gate": nrm(ks[13], (DEPTH, D_MODEL, D_MODEL), D_MODEL ** -0.5),
        "ple_proj": nrm(ks[14], (DEPTH, PLE_DIM, D_MODEL), DN_BETA * PLE_DIM ** -0.5),
        "ln2_g": 1.0 + nrm(ks[15], (DEPTH, D_MODEL), 0.02),
        "ln2_b": nrm(ks[16], (DEPTH, D_MODEL), 0.02),
    }


def reference(x, p, w_in, sinks, w_branch_a, w_branch_b, w_out, ln1_g, ln1_b,
              peer_wq, peer_subkeys, peer_u, peer_v, ple_gate, ple_proj, ln2_g, ln2_b):
    cos, sin = rope_tables(x.shape[1])
    for i in range(DEPTH):
        mix = hybrid_mixer(x, cos, sin, w_in[i], sinks[i], w_branch_a[i], w_branch_b[i], w_out[i])
        h1 = layer_norm(DN_ALPHA * x + mix, ln1_g[i], ln1_b[i])
        ffn = peer_ffn(h1, peer_wq[i], peer_subkeys[i], peer_u[i], peer_v[i])
        ple = jax.nn.sigmoid(h1 @ ple_gate[i]) * (p[i] @ ple_proj[i])
        x = layer_norm(DN_ALPHA * h1 + ffn + ple, ln2_g[i], ln2_b[i])
    return x
```

```cpp
#include <hip/hip_runtime.h>
#include <cstdio>
#include <cstdint>
namespace pg8 {
#define PG8_LAS __attribute__((address_space(3)))
typedef unsigned short bf16_t;
typedef short bf16x8 __attribute__((ext_vector_type(8)));
typedef float f32x4 __attribute__((ext_vector_type(4)));
typedef unsigned u32x4 __attribute__((ext_vector_type(4)));
constexpr int BM = 256, BK = 64, HALF = 128, HTB = HALF * BK * 2  , STAGE_BYTES = 8 * HTB, NXCD = 8, WGM = 8;

__host__ __device__ __forceinline__ int lds_byte(int r, int c) { const int st = (r >> 4) * 2 + (c >> 5), rr = r & 15, cc = c & 31, ob = rr * 64 + cc * 2; return st * 1024 + (ob ^ (((ob >> 9) & 1) << 5)); }
__host__ __device__ __forceinline__ void stage_rc(int b, int& R, int& C) { const int st = b / 1024, sb = b % 1024, swz = sb ^ (((sb >> 9) & 1) << 5); R = (st >> 1) * 16 + swz / 64; C = (st & 1) * 32 + (swz % 64) / 2; }
__host__ __device__ __forceinline__ int perm32(int rho) { const int n = rho >> 4, i = rho & 15; return 8 * (i >> 2) + 4 * n + (i & 3); }

struct Unit { int pm, pn; };
struct Gemm { const bf16_t* A; const bf16_t* Bt; int M, N, K; };

struct StaticOrder {
    int nM, nN, nwg, G, c;
    __host__ __device__ void init(int M, int N, int G_, int c_) { nM = M / BM; nN = N / BM; nwg = nM * nN; G = G_; c = c_; }
    __host__ __device__ bool next(int i, Unit& u) const {
        const long L = (long)i * G + c; if (L >= nwg) return false;
        int wgid = (int)L; { const int q = nwg / NXCD, r = nwg % NXCD, xcd = wgid % NXCD, off = wgid / NXCD; wgid = (xcd < r ? xcd * (q + 1) : r * (q + 1) + (xcd - r) * q) + off; }
        const int nig = WGM * nN, gid = wgid / nig, fm = gid * WGM, gsz = (nM - fm) < WGM ? (nM - fm) : WGM;
        u.pm = fm + ((wgid % nig) % gsz); u.pn = (wgid % nig) / gsz; return true;
    }
    __device__ __forceinline__ void a_ready(const Unit&) const {}
    __device__ __forceinline__ void done(const Unit&) const {}
};

typedef float f32x2_t __attribute__((ext_vector_type(2))); typedef __bf16 bf16x2_t __attribute__((ext_vector_type(2)));
__device__ __forceinline__ unsigned cvt_pk_bf16(float lo, float hi) { const f32x2_t v = {lo, hi}; const bf16x2_t b = __builtin_convertvector(v, bf16x2_t); return __builtin_bit_cast(unsigned, b); }
typedef unsigned u32x2 __attribute__((ext_vector_type(2)));
__device__ __forceinline__ float bf_lo(unsigned w) { return __builtin_bit_cast(float, w << 16); }
__device__ __forceinline__ float bf_hi(unsigned w) { return __builtin_bit_cast(float, w & 0xffff0000u); }
__device__ __forceinline__ float sigmoidf_(float x) { return __builtin_amdgcn_rcpf(1.0f + __builtin_amdgcn_exp2f(-1.4426950408889634f * x)); }
__device__ __forceinline__ u32x4 pack8(f32x4 a, f32x4 b) { u32x4 w; w.x = cvt_pk_bf16(a[0], a[1]); w.y = cvt_pk_bf16(a[2], a[3]); w.z = cvt_pk_bf16(b[0], b[1]); w.w = cvt_pk_bf16(b[2], b[3]); return w; }
__device__ __forceinline__ void unpack8(u32x4 w, f32x4& a, f32x4& b) { a = (f32x4){bf_lo(w.x), bf_hi(w.x), bf_lo(w.y), bf_hi(w.y)}; b = (f32x4){bf_lo(w.z), bf_hi(w.z), bf_lo(w.w), bf_hi(w.w)}; }

struct EpiQKV {
    static constexpr bool PERM = true, AFTER_DRAIN = false;
    bf16_t *QA, *KA, *VA, *QB, *KB, *VB, *G; const float *COS, *SIN;
    __device__ __forceinline__ void operator()(const f32x4 (&acc)[2][2][4][2], const Unit& u, int wr, int wc, int fr, int fq) const {
        const int pn = u.pn; const int row0 = u.pm * BM + wr * 64 + fr;
        if (pn >= 24) {
            const int col0 = (pn - 24) * 256 + wc * 32 + 8 * fq;
#pragma unroll
            for (int ai = 0; ai < 2; ++ai)
#pragma unroll
                for (int m = 0; m < 4; ++m) { bf16_t* rowp = G + (size_t)(row0 + ai * HALF + m * 16) * 4096 + col0;
#pragma unroll
                    for (int bj = 0; bj < 2; ++bj) { f32x4 v0 = acc[ai][bj][m][0], v1 = acc[ai][bj][m][1];
#pragma unroll
                        for (int i = 0; i < 4; ++i) { v0[i] = sigmoidf_(v0[i]); v1[i] = sigmoidf_(v1[i]); }
                        *(u32x4*)(rowp + bj * HALF) = pack8(v0, v1); } }
        } else {
            bf16_t* base; int nh, j0; bool rope;
            if (pn < 6) { base = QA; nh = 12; j0 = 2 * pn; rope = true; }
            else if (pn < 12) { base = KA; nh = 12; j0 = 2 * (pn - 6); rope = true; }
            else if (pn < 18) { base = VA; nh = 12; j0 = 2 * (pn - 12); rope = false; }
            else if (pn < 22) { base = QB; nh = 8; j0 = 2 * (pn - 18); rope = true; }
            else if (pn == 22) { base = KB; nh = 2; j0 = 0; rope = true; }
            else { base = VB; nh = 2; j0 = 0; rope = false; }
            const int dsh = (nh == 12) ? 2 * (j0 >> 2) : 0;
            if (rope) {
                const int i0 = 16 * wc + 4 * fq;
#pragma unroll
                for (int ai = 0; ai < 2; ++ai)
#pragma unroll
                    for (int m = 0; m < 4; ++m) { const int row = row0 + ai * HALF + m * 16, b = row >> 12, s = row & 4095;
                        const int rih = ((s & ((1 << dsh) - 1)) << (12 - dsh)) + (s >> dsh);
                        const f32x4 c4 = *(const f32x4*)(COS + s * 64 + i0), s4 = *(const f32x4*)(SIN + s * 64 + i0);
#pragma unroll
                        for (int bj = 0; bj < 2; ++bj) { bf16_t* dst = base + ((size_t)(b * nh + j0 + bj) * 4096 + rih) * 128 + i0;
                            const f32x4 v0 = acc[ai][bj][m][0], v1 = acc[ai][bj][m][1];
                            const f32x4 o1 = v0 * c4 - v1 * s4, o2 = v0 * s4 + v1 * c4;
                            u32x2 w1, w2; w1.x = cvt_pk_bf16(o1[0], o1[1]); w1.y = cvt_pk_bf16(o1[2], o1[3]); w2.x = cvt_pk_bf16(o2[0], o2[1]); w2.y = cvt_pk_bf16(o2[2], o2[3]);
                            *(u32x2*)dst = w1; *(u32x2*)(dst + 64) = w2; } }
            } else {
                const int p0 = 32 * wc + 8 * fq;
#pragma unroll
                for (int ai = 0; ai < 2; ++ai)
#pragma unroll
                    for (int m = 0; m < 4; ++m) { const int row = row0 + ai * HALF + m * 16, b = row >> 12, s = row & 4095;
                        const int rih = ((s & ((1 << dsh) - 1)) << (12 - dsh)) + (s >> dsh);
#pragma unroll
                        for (int bj = 0; bj < 2; ++bj) { bf16_t* dst = base + ((size_t)(b * nh + j0 + bj) * 4096 + rih) * 128 + p0;
                            *(u32x4*)dst = pack8(acc[ai][bj][m][0], acc[ai][bj][m][1]); } }
            }
        }
    }
};
struct EpiBranchA {
    static constexpr bool PERM = true, AFTER_DRAIN = false;
    bf16_t* G;
    __device__ __forceinline__ void operator()(const f32x4 (&acc)[2][2][4][2], const Unit& u, int wr, int wc, int fr, int fq) const {
        const int row0 = u.pm * BM + wr * 64 + fr, col0 = u.pn * BM + wc * 32 + 8 * fq;
#pragma unroll
        for (int ai = 0; ai < 2; ++ai)
#pragma unroll
            for (int m = 0; m < 4; ++m) { bf16_t* rowp = G + (size_t)(row0 + ai * HALF + m * 16) * 4096 + col0;
#pragma unroll
                for (int bj = 0; bj < 2; ++bj) { f32x4 g0, g1; unpack8(*(const u32x4*)(rowp + bj * HALF), g0, g1);
                    *(u32x4*)(rowp + bj * HALF) = pack8(g0 * acc[ai][bj][m][0], g1 * acc[ai][bj][m][1]); } }
    }
};
struct EpiBranchB {
    static constexpr bool PERM = true, AFTER_DRAIN = false;
    const bf16_t* G; bf16_t* O;
    __device__ __forceinline__ void operator()(const f32x4 (&acc)[2][2][4][2], const Unit& u, int wr, int wc, int fr, int fq) const {
        const int row0 = u.pm * BM + wr * 64 + fr, col0 = u.pn * BM + wc * 32 + 8 * fq;
#pragma unroll
        for (int ai = 0; ai < 2; ++ai)
#pragma unroll
            for (int m = 0; m < 4; ++m) { const size_t row = (size_t)(row0 + ai * HALF + m * 16); const bf16_t* gp = G + row * 4096 + col0; bf16_t* op = O + row * 2048 + col0;
#pragma unroll
                for (int bj = 0; bj < 2; ++bj) { f32x4 t0, t1, g0, g1; unpack8(*(const u32x4*)(gp + bj * HALF), t0, t1); unpack8(*(const u32x4*)(gp + 2048 + bj * HALF), g0, g1);
                    *(u32x4*)(op + bj * HALF) = pack8(t0 + g0 * acc[ai][bj][m][0], t1 + g1 * acc[ai][bj][m][1]); } }
    }
};
struct EpiWout {
    static constexpr bool PERM = false, AFTER_DRAIN = false;
    const float* X; float* Y; float alpha;
    __device__ __forceinline__ void operator()(const f32x4 (&acc)[2][2][4][2], const Unit& u, int wr, int wc, int fr, int fq) const {
        const int row0 = u.pm * BM + wr * 64 + fr, col0 = u.pn * BM + wc * 32 + 4 * fq;
#pragma unroll
        for (int ai = 0; ai < 2; ++ai)
#pragma unroll
            for (int m = 0; m < 4; ++m) { const size_t off = (size_t)(row0 + ai * HALF + m * 16) * 2048 + col0;
#pragma unroll
                for (int bj = 0; bj < 2; ++bj)
#pragma unroll
                    for (int n = 0; n < 2; ++n) { const f32x4 xv = *(const f32x4*)(X + off + bj * HALF + n * 16); *(f32x4*)(Y + off + bj * HALF + n * 16) = xv * alpha + acc[ai][bj][m][n]; } }
    }
};
struct EpiPlain {
    static constexpr bool PERM = true, AFTER_DRAIN = false;
    bf16_t* O; int ldc;
    __device__ __forceinline__ void operator()(const f32x4 (&acc)[2][2][4][2], const Unit& u, int wr, int wc, int fr, int fq) const {
        const int row0 = u.pm * BM + wr * 64 + fr, col0 = u.pn * BM + wc * 32 + 8 * fq;
#pragma unroll
        for (int ai = 0; ai < 2; ++ai)
#pragma unroll
            for (int m = 0; m < 4; ++m) { bf16_t* rowp = O + (size_t)(row0 + ai * HALF + m * 16) * ldc + col0;
#pragma unroll
                for (int bj = 0; bj < 2; ++bj) *(u32x4*)(rowp + bj * HALF) = pack8(acc[ai][bj][m][0], acc[ai][bj][m][1]); }
    }
};
struct EpiQG {
    static constexpr bool PERM = true, AFTER_DRAIN = false;
    bf16_t* Q; bf16_t* PP;
    __device__ __forceinline__ void operator()(const f32x4 (&acc)[2][2][4][2], const Unit& u, int wr, int wc, int fr, int fq) const {
        const int row0 = u.pm * BM + wr * 64 + fr; const bool isq = u.pn < 8; const int col0 = (u.pn & 7) * BM + wc * 32 + 8 * fq;
        bf16_t* base = isq ? Q : PP;
#pragma unroll
        for (int ai = 0; ai < 2; ++ai)
#pragma unroll
            for (int m = 0; m < 4; ++m) { bf16_t* rowp = base + (size_t)(row0 + ai * HALF + m * 16) * 2048 + col0;
#pragma unroll
                for (int bj = 0; bj < 2; ++bj) { f32x4 v0 = acc[ai][bj][m][0], v1 = acc[ai][bj][m][1];
                    if (!isq) { f32x4 p0, p1; unpack8(*(const u32x4*)(rowp + bj * HALF), p0, p1);
#pragma unroll
                        for (int i = 0; i < 4; ++i) { v0[i] = sigmoidf_(v0[i]) * p0[i]; v1[i] = sigmoidf_(v1[i]) * p1[i]; } }
                    *(u32x4*)(rowp + bj * HALF) = pack8(v0, v1); } }
    }
};
template <class Epi, class Sched, bool ALIGN_EPI = false, bool SP2 = false>
__device__ __forceinline__ void gemm_phase(PG8_LAS unsigned char* lds, const Gemm g, const Sched& S, const Epi& E) {
    const int tid = threadIdx.x, wid = __builtin_amdgcn_readfirstlane(tid >> 6), lane = tid & 63, wr = wid >> 2, wc = wid & 3, fr = lane & 15, fq = lane >> 4;
    const int K = g.K, nt = K / BK;
    unsigned voffA[2], voffB[2];
#pragma unroll
    for (int i = 0; i < 2; ++i) { int R, C; stage_rc(tid * 16 + i * 8192, R, C); const int Rb = Epi::PERM ? ((R & ~31) + perm32(R & 31)) : R;
        voffA[i] = (unsigned)(R * K + C) * 2u; voffB[i] = (unsigned)(Rb * K + C) * 2u; }
    const size_t kstep = (size_t)(BK * 2);
    const size_t hstep = (size_t)HALF * K * 2;
    const size_t tstep = 2 * hstep;
    const unsigned ldsw = (unsigned)wid * 1024u;
    const int aoff = lds_byte(wr * 64 + fr, fq * 8), boff = lds_byte(wc * 32 + fr, fq * 8);
#define PG8_SA(b, h) (((b) * 2 + (h)) * HTB)
#define PG8_SB(b, h) ((4 + (b) * 2 + (h)) * HTB)
#define PG8_STAGE(bufoff, gbase, voff) do { _Pragma("unroll") for (int _i = 0; _i < 2; ++_i) \
        __builtin_amdgcn_global_load_lds((const unsigned*)((const char*)(gbase) + (voff)[_i]), (PG8_LAS unsigned*)(lds + (bufoff) + ldsw + _i * 8192), 16, 0, 0); } while (0)
#define PG8_LDA(dst, b, h) do { _Pragma("unroll") for (int m = 0; m < 4; ++m) _Pragma("unroll") for (int k = 0; k < 2; ++k) dst[m][k] = *(const PG8_LAS bf16x8*)(lds + PG8_SA(b, h) + aoff + m * 2048 + k * 1024); } while (0)
#define PG8_LDB(dst, b, h) do { _Pragma("unroll") for (int n = 0; n < 2; ++n) _Pragma("unroll") for (int k = 0; k < 2; ++k) dst[n][k] = *(const PG8_LAS bf16x8*)(lds + PG8_SB(b, h) + boff + n * 2048 + k * 1024); } while (0)
#define PG8_MMA(ai, bj, At, Bt) do { __builtin_amdgcn_s_setprio(1); _Pragma("unroll") for (int m = 0; m < 4; ++m) _Pragma("unroll") for (int n = 0; n < 2; ++n) _Pragma("unroll") for (int k = 0; k < 2; ++k) \
        acc[ai][bj][m][n] = __builtin_amdgcn_mfma_f32_16x16x32_bf16(Bt[n][k], At[m][k], acc[ai][bj][m][n], 0, 0, 0); __builtin_amdgcn_s_setprio(0); } while (0)
#define PG8_WAIT_V(n) asm volatile("s_waitcnt vmcnt(" #n ")" ::: "memory")
#define PG8_WAIT_L(n) asm volatile("s_waitcnt lgkmcnt(" #n ")" ::: "memory")
#define PG8_BAR __builtin_amdgcn_s_barrier()
#define PG8_SCHED __builtin_amdgcn_sched_barrier(0)
    Unit cur, nxt; int ui = 0;
    if (!S.next(0, cur)) return;
    f32x4 acc[2][2][4][2];
#pragma unroll
    for (int a = 0; a < 2; ++a)
#pragma unroll
        for (int b = 0; b < 2; ++b)
#pragma unroll
            for (int m = 0; m < 4; ++m)
#pragma unroll
                for (int n = 0; n < 2; ++n) acc[a][b][m][n] = (f32x4){0.f, 0.f, 0.f, 0.f};
    bf16x8 At[4][2], B0[2][2], B1[2][2];
    const char* cA = (const char*)g.A + (size_t)cur.pm * tstep; const char* cB = (const char*)g.Bt + (size_t)cur.pn * tstep;
    S.a_ready(cur);
    if constexpr (SP2) {
        PG8_STAGE(PG8_SB(0, 0), cB, voffB); PG8_STAGE(PG8_SB(0, 1), cB + hstep, voffB); PG8_STAGE(PG8_SA(0, 0), cA, voffA); PG8_STAGE(PG8_SA(0, 1), cA + hstep, voffA);
        if (wr == 1) PG8_BAR;
        PG8_WAIT_V(2); PG8_BAR;
        PG8_STAGE(PG8_SB(1, 0), cB + kstep, voffB); PG8_STAGE(PG8_SA(1, 0), cA + kstep, voffA); PG8_STAGE(PG8_SB(1, 1), cB + hstep + kstep, voffB);
        PG8_WAIT_V(6); PG8_BAR;
    } else {
        PG8_STAGE(PG8_SB(0, 0), cB, voffB); PG8_STAGE(PG8_SA(0, 0), cA, voffA); PG8_STAGE(PG8_SB(0, 1), cB + hstep, voffB); PG8_STAGE(PG8_SA(0, 1), cA + hstep, voffA);
        if (wr == 1) PG8_BAR;
        PG8_WAIT_V(4); PG8_BAR;
        PG8_STAGE(PG8_SB(1, 0), cB + kstep, voffB); PG8_STAGE(PG8_SA(1, 0), cA + kstep, voffA); PG8_STAGE(PG8_SB(1, 1), cB + hstep + kstep, voffB);
        PG8_WAIT_V(6); PG8_BAR;
    }
    for (;;) {
        const bool has_next = S.next(ui + 1, nxt);
        const char* nA = has_next ? (const char*)g.A + (size_t)nxt.pm * tstep : cA; const char* nB = has_next ? (const char*)g.Bt + (size_t)nxt.pn * tstep : cB;
        for (int t = 0; t < nt; t += 2) {
            const bool last = (t == nt - 2);
            const char* a1 = cA + (size_t)(t + 1) * kstep;
            const char* a2 = last ? nA : cA + (size_t)(t + 2) * kstep; const char* b2 = last ? nB : cB + (size_t)(t + 2) * kstep;
            const char* a3 = a2 + kstep; const char* b3 = b2 + kstep;
            if (last && has_next) S.a_ready(nxt);
            if constexpr (SP2) {
            PG8_LDB(B0, 0, 0); PG8_LDB(B1, 0, 1); PG8_SCHED; PG8_LDA(At, 0, 0); PG8_STAGE(PG8_SA(1, 1), a1 + hstep, voffA);
            PG8_WAIT_V(8); PG8_WAIT_L(0); PG8_BAR; PG8_MMA(0, 0, At, B0); PG8_MMA(0, 1, At, B1); PG8_BAR; PG8_SCHED;
            PG8_LDA(At, 0, 1); PG8_STAGE(PG8_SB(0, 0), b2, voffB); PG8_STAGE(PG8_SB(0, 1), b2 + hstep, voffB); PG8_STAGE(PG8_SA(0, 0), a2, voffA);
            PG8_WAIT_V(8); PG8_WAIT_L(0); PG8_BAR; PG8_MMA(1, 0, At, B0); PG8_MMA(1, 1, At, B1); PG8_BAR; PG8_SCHED;
            PG8_LDB(B0, 1, 0); PG8_LDB(B1, 1, 1); PG8_SCHED; PG8_LDA(At, 1, 0); PG8_STAGE(PG8_SA(0, 1), a2 + hstep, voffA);
            PG8_WAIT_V(8); PG8_WAIT_L(0); PG8_BAR; PG8_MMA(0, 0, At, B0); PG8_MMA(0, 1, At, B1); PG8_BAR; PG8_SCHED;
            PG8_LDA(At, 1, 1); PG8_STAGE(PG8_SB(1, 0), b3, voffB); PG8_STAGE(PG8_SB(1, 1), b3 + hstep, voffB); PG8_STAGE(PG8_SA(1, 0), a3, voffA);
            PG8_WAIT_V(8); PG8_WAIT_L(0); PG8_BAR; PG8_MMA(1, 0, At, B0); PG8_MMA(1, 1, At, B1); PG8_BAR; PG8_SCHED;
            } else {
            PG8_LDB(B0, 0, 0); PG8_SCHED; PG8_LDA(At, 0, 0); PG8_STAGE(PG8_SA(1, 1), a1 + hstep, voffA);
            PG8_WAIT_L(8); PG8_BAR; PG8_WAIT_L(0); PG8_MMA(0, 0, At, B0); PG8_BAR; PG8_SCHED;
            PG8_LDB(B1, 0, 1); PG8_STAGE(PG8_SB(0, 0), b2, voffB);
            PG8_BAR; PG8_WAIT_L(0); PG8_MMA(0, 1, At, B1); PG8_BAR;
            PG8_LDA(At, 0, 1); PG8_STAGE(PG8_SA(0, 0), a2, voffA);
            PG8_BAR; PG8_WAIT_L(0); PG8_MMA(1, 0, At, B0); PG8_BAR; PG8_SCHED;
            PG8_STAGE(PG8_SB(0, 1), b2 + hstep, voffB);
            PG8_WAIT_V(6); PG8_BAR; PG8_MMA(1, 1, At, B1); PG8_BAR;
            PG8_LDB(B0, 1, 0); PG8_SCHED; PG8_LDA(At, 1, 0); PG8_STAGE(PG8_SA(0, 1), a2 + hstep, voffA);
            PG8_WAIT_L(8); PG8_BAR; PG8_WAIT_L(0); PG8_MMA(0, 0, At, B0); PG8_BAR; PG8_SCHED;
            PG8_LDB(B1, 1, 1); PG8_STAGE(PG8_SB(1, 0), b3, voffB);
            PG8_BAR; PG8_WAIT_L(0); PG8_MMA(0, 1, At, B1); PG8_BAR;
            PG8_LDA(At, 1, 1); PG8_STAGE(PG8_SA(1, 0), a3, voffA);
            PG8_BAR; PG8_WAIT_L(0); PG8_MMA(1, 0, At, B0); PG8_BAR; PG8_SCHED;
            PG8_STAGE(PG8_SB(1, 1), b3 + hstep, voffB);
            PG8_WAIT_V(6); PG8_BAR; PG8_MMA(1, 1, At, B1); PG8_BAR;
            }
        }
        if constexpr (ALIGN_EPI) { if (wr == 0) PG8_BAR; }
        if constexpr (!Epi::AFTER_DRAIN) { E(acc, cur, wr, wc, fr, fq); S.done(cur); }
        if (!has_next) break;
#pragma unroll
        for (int a = 0; a < 2; ++a)
#pragma unroll
            for (int b = 0; b < 2; ++b)
#pragma unroll
                for (int m = 0; m < 4; ++m)
#pragma unroll
                    for (int n = 0; n < 2; ++n) acc[a][b][m][n] = (f32x4){0.f, 0.f, 0.f, 0.f};
        cur = nxt; cA = nA; cB = nB; ++ui;
        if constexpr (ALIGN_EPI) { if (wr == 1) PG8_BAR; }
    }
    PG8_WAIT_V(0);
    if constexpr (!ALIGN_EPI) { if (wr == 0) PG8_BAR; }
    PG8_BAR;
    if constexpr (Epi::AFTER_DRAIN) { E.fused(acc, cur, wr, wc, fr, fq, lds, wid, lane); S.done(cur); }
#undef PG8_SA
#undef PG8_SB
#undef PG8_STAGE
#undef PG8_LDA
#undef PG8_LDB
#undef PG8_MMA
#undef PG8_WAIT_V
#undef PG8_WAIT_L
#undef PG8_BAR
#undef PG8_SCHED
}
}
constexpr int NWAVES = 8;
constexpr int NB = 4, S = 4096, D = 2048, T = NB * S;
constexpr int IN_COLS = 10240, NQG = 4096;
constexpr int NPHASES = 11;
#ifndef MK_N_LAUNCHES
#define MK_N_LAUNCHES 1
#endif
constexpr int N_LAUNCHES = MK_N_LAUNCHES;
constexpr float LN_EPS = 1e-5f;
constexpr float DN_ALPHA = 1.189207115002721f;
constexpr size_t MiB = 1u << 20;
constexpr size_t WS_CTL = 0, CTL_ZERO_BYTES = 1 * MiB;
constexpr size_t WS_COS = 1 * MiB, WS_SIN = 2 * MiB;
constexpr size_t WS_WBA = 3 * MiB;
constexpr size_t WS_WBB = 5 * MiB;
constexpr size_t WS_WOUT = 9 * MiB;
constexpr size_t WS_WQG = 17 * MiB;
constexpr size_t WS_WPP = 33 * MiB;
constexpr size_t WS_SK = 34 * MiB;
constexpr size_t WS_PB = 35 * MiB;
constexpr size_t WS_QA = 43 * MiB, WS_KA = 91 * MiB, WS_VA = 139 * MiB;
constexpr size_t WS_QB = 187 * MiB, WS_KB = 219 * MiB, WS_VB = 227 * MiB;
constexpr size_t WS_UB = 43 * MiB, WS_VT = 107 * MiB;
constexpr size_t WS_MERGED = 171 * MiB;
constexpr size_t WS_Q = 171 * MiB;
constexpr size_t WS_G = 235 * MiB;
constexpr size_t WS_H1 = 235 * MiB;
constexpr size_t WS_WIN = 363 * MiB;
constexpr size_t WS_XB = 403 * MiB;
constexpr size_t WS_OG = 363 * MiB;
constexpr size_t WS_ML = 411 * MiB;
constexpr size_t WS_OB = 413 * MiB;
constexpr size_t WS_OA = 445 * MiB;
constexpr size_t WS_H1B = 363 * MiB;
constexpr size_t WS_PP = 427 * MiB;
constexpr size_t WS_IDX = 491 * MiB, WS_GATE = 499 * MiB;
constexpr size_t WS_END = 507 * MiB;
constexpr int CW_BAR = 4096;
constexpr int RING_OFF = 0, RING_BYTES = 131072;
constexpr int LDSCTL_OFF = RING_BYTES, MISC_OFF = LDSCTL_OFF + 320;
constexpr int LDS_BYTES = 147456;
#define GAS __attribute__((address_space(1)))
#define LAS __attribute__((address_space(3)))
typedef unsigned short bf16;
typedef unsigned v4u __attribute__((ext_vector_type(4)));
typedef float f32x4 __attribute__((ext_vector_type(4)));
typedef short bf16x8 __attribute__((ext_vector_type(8)));
typedef GAS unsigned gu32;
typedef GAS unsigned long long gu64;
#define RLX_AGENT __ATOMIC_RELAXED, __HIP_MEMORY_SCOPE_AGENT
#define LDS_WAIT() asm volatile("s_waitcnt lgkmcnt(0)" ::: "memory")
#define VM_WAIT() asm volatile("s_waitcnt vmcnt(0)" ::: "memory")
__device__ __forceinline__ unsigned long long rt() { return __builtin_amdgcn_s_memrealtime(); }
__device__ __forceinline__ unsigned f2bf(float f) { unsigned u = __builtin_bit_cast(unsigned, f); return (u + 0x7fffu + ((u >> 16) & 1u)) >> 16; }
__device__ __forceinline__ unsigned pk2(float lo, float hi) { return f2bf(lo) | (f2bf(hi) << 16); }

#define XB_TMO      128
#define XB_XCNT(j)  (256  + 64 * (j))
#define XB_XSUB(j)  (1280 + 64 * (j))
#define XB_XGEN(j)  (2304 + 64 * (j))
#define XB_TOP      3328
#define XB_TOPGEN   3392
#define XCD_BAR_WORDS 3456
#define XB_SPIN_CAP (1u << 18)

__device__ __forceinline__ unsigned xb_ld(unsigned* p)              { return __hip_atomic_load(p, __ATOMIC_RELAXED, __HIP_MEMORY_SCOPE_AGENT); }
__device__ __forceinline__ unsigned xb_add(unsigned* p, unsigned v) { return __hip_atomic_fetch_add(p, v, __ATOMIC_RELAXED, __HIP_MEMORY_SCOPE_AGENT); }
__device__ __forceinline__ unsigned xb_xcc_id() { return (unsigned)__builtin_amdgcn_s_getreg((3 << 11) | 20) & 0xFu; }
#define XB_SPIN(cond, bar) do { unsigned _sp = 0; while (cond) { __builtin_amdgcn_s_sleep(1); \
    if ((++_sp & 255u) == 0u) { if (xb_ld(&(bar)[XB_TMO])) break; if (_sp > XB_SPIN_CAP) { atomicAdd(&(bar)[XB_TMO], 1u); break; } } } } while (0)

struct XcdBarrier {
    unsigned* bar; unsigned x;
    volatile LAS unsigned* st;
};

__device__ __forceinline__ XcdBarrier xcd_barrier_post(unsigned* bar, volatile LAS unsigned* st) {
    XcdBarrier b; b.bar = bar; b.x = xb_xcc_id(); b.st = st;
    if (threadIdx.x == 0) (void)xb_add(&bar[XB_XCNT(b.x)], 1u);
    return b;
}
__device__ __forceinline__ void xcd_barrier_complete(unsigned* bar, unsigned x, unsigned& nloc, unsigned& nx) {
    const unsigned G = gridDim.x * gridDim.y * gridDim.z;
    unsigned sum, cnt, mine, sp = 0u;
    for (;;) {
        sum = 0u; cnt = 0u; mine = 0u;
#pragma unroll
        for (unsigned j = 0; j < 16; ++j) { const unsigned c = xb_ld(&bar[XB_XCNT(j)]); sum += c; cnt += (c > 0u) ? 1u : 0u; mine = (j == x) ? c : mine; }
        if (sum == G) break;
        __builtin_amdgcn_s_sleep(1);
        if ((++sp & 255u) == 0u) { if (xb_ld(&bar[XB_TMO])) break; if (sp > XB_SPIN_CAP) { atomicAdd(&bar[XB_TMO], 1u); break; } }
    }
    nloc = mine > 0u ? mine : 1u; nx = cnt > 0u ? cnt : 1u;
}

__device__ __forceinline__ void xcd_barrier(const XcdBarrier& b) {
    asm volatile("s_waitcnt vmcnt(0)" ::: "memory");
    __syncthreads();
    if (threadIdx.x == 0) {
        unsigned* bar = b.bar;
        __builtin_amdgcn_s_waitcnt(0);
        unsigned nloc = b.st[0], nx = b.st[1];
        if (nloc == 0u) { xcd_barrier_complete(bar, b.x, nloc, nx); b.st[0] = nloc; b.st[1] = nx; }
        const unsigned old = xb_add(&bar[XB_XSUB(b.x)], 1u);
        const unsigned gen = old / nloc;
        if (old + 1u == (gen + 1u) * nloc) {
            __builtin_amdgcn_fence(__ATOMIC_RELEASE, "agent");
            asm volatile("s_waitcnt vmcnt(0)" ::: "memory");
            const unsigned og = xb_add(&bar[XB_TOP], 1u);
            const unsigned tg = og / nx;
            if (og + 1u == (tg + 1u) * nx) xb_add(&bar[XB_TOPGEN], 1u);
            else XB_SPIN(xb_ld(&bar[XB_TOPGEN]) == tg, bar);
            __builtin_amdgcn_fence(__ATOMIC_ACQUIRE, "agent");
            xb_add(&bar[XB_XGEN(b.x)], 1u);
            asm volatile("s_waitcnt vmcnt(0)" ::: "memory");
        } else {
            XB_SPIN(xb_ld(&bar[XB_XGEN(b.x)]) == gen, bar);
            __builtin_amdgcn_fence(__ATOMIC_ACQUIRE, "agent");
            asm volatile("s_waitcnt vmcnt(0)" ::: "memory");
        }
    }
    __syncthreads();
}
typedef float f32x2v __attribute__((ext_vector_type(2)));
typedef int i32x4 __attribute__((ext_vector_type(4)));
typedef __bf16 bf16x2_t __attribute__((ext_vector_type(2)));
__device__ __forceinline__ float bf_lo_(unsigned w) { return __builtin_bit_cast(float, w << 16); }
__device__ __forceinline__ float bf_hi_(unsigned w) { return __builtin_bit_cast(float, w & 0xffff0000u); }
struct Frame {
    LAS unsigned char* lds;
    volatile LAS unsigned* MISC;
    gu32* ctl;
    int wave;
    int vcu, G;
    unsigned char* ws;
};
__device__ __forceinline__ int tid_() { return (int)threadIdx.x; }
__device__ __forceinline__ int lane_() { return (int)(threadIdx.x & 63u); }
__device__ __forceinline__ float wave_sum(float v) {
#pragma unroll
    for (int o = 1; o < 64; o <<= 1) v += __shfl_xor(v, o);
    return v;
}
__device__ __forceinline__ int win_dest_row(int c) {
    const bool rope = (c < 3072) || (c >= 4608 && c < 5888);
    const int d = c & 127; const int pp = (((d & 63) >> 2) << 3) + ((d >> 6) << 2) + (d & 3);
    return rope ? ((c & ~127) + pp) : c;
}
template <bool WIN_MAP>
__device__ __forceinline__ void p0_transpose_item(const float* W, int K, int N, bf16* WT, int row_off, LAS float* scr, int item, int lane) {
    const int nblk = N / 32, kb = item / nblk, nb = item % nblk, k0 = 64 * kb, n0 = 32 * nb;
#pragma unroll 8
    for (int i = 0; i < 32; ++i) { const int kk = 2 * i + (lane >> 5); scr[kk * 33 + (lane & 31)] = W[(size_t)(k0 + kk) * N + n0 + (lane & 31)]; }
    LDS_WAIT(); asm volatile("" ::: "memory");
    const int c = lane & 7;
#pragma unroll
    for (int j = 0; j < 4; ++j) { const int n = (lane >> 3) + 8 * j; const LAS float* s = scr + (8 * c) * 33 + n;
        v4u o; o.x = pk2(s[0 * 33], s[1 * 33]); o.y = pk2(s[2 * 33], s[3 * 33]); o.z = pk2(s[4 * 33], s[5 * 33]); o.w = pk2(s[6 * 33], s[7 * 33]);
        const int drow = WIN_MAP ? win_dest_row(n0 + n) : (row_off + n0 + n);
        *(GAS v4u*)(WT + (size_t)drow * K + k0 + 8 * c) = o; }
    LDS_WAIT(); asm volatile("" ::: "memory");
}
__device__ __forceinline__ void cvt_copy(Frame& F, const float* src, bf16* dst, size_t n) {
    const size_t nthr = (size_t)F.G * NWAVES * 64, gt = (size_t)F.vcu * NWAVES * 64 + tid_();
    for (size_t i = gt; i < n / 8; i += nthr) { const f32x4 a = *(const GAS f32x4*)(src + i * 8), b = *(const GAS f32x4*)(src + i * 8 + 4);
        v4u o; o.x = pk2(a.x, a.y); o.y = pk2(a.z, a.w); o.z = pk2(b.x, b.y); o.w = pk2(b.z, b.w); *(GAS v4u*)(dst + i * 8) = o; }
}
__device__ __forceinline__ void p0_prologue(Frame& F, const float* x, const float* p, const float* w_in, const float* wba, const float* wbb, const float* w_out, const float* wq, const float* subkeys, const float* ple_gate, const float* ple_proj) {
    const int lane = lane_();
    LAS float* scr = (LAS float*)(F.lds + RING_OFF + F.wave * 16384);
    const int gw = F.vcu * NWAVES + F.wave, NGW = F.G * NWAVES;
    bf16* WIN = (bf16*)(F.ws + WS_WIN); bf16* WBA = (bf16*)(F.ws + WS_WBA); bf16* WBB = (bf16*)(F.ws + WS_WBB); bf16* WOUT = (bf16*)(F.ws + WS_WOUT);
    bf16* WQG = (bf16*)(F.ws + WS_WQG); bf16* WPP = (bf16*)(F.ws + WS_WPP);
    constexpr int I_IN = (D / 64) * (IN_COLS / 32), I_BA = (512 / 64) * (D / 32), I_BB = (1024 / 64) * (D / 32), I_SQ = (D / 64) * (D / 32), I_PP = (256 / 64) * (D / 32);
    constexpr int NITEMS = I_IN + I_BA + I_BB + 3 * I_SQ + I_PP;
    for (int it = gw; it < NITEMS; it += NGW) {
        int r = it;
        if (r < I_IN) { p0_transpose_item<true>(w_in, D, IN_COLS, WIN, 0, scr, r, lane); continue; } r -= I_IN;
        if (r < I_BA) { p0_transpose_item<false>(wba, 512, D, WBA, 0, scr, r, lane); continue; } r -= I_BA;
        if (r < I_BB) { p0_transpose_item<false>(wbb, 1024, D, WBB, 0, scr, r, lane); continue; } r -= I_BB;
        if (r < I_SQ) { p0_transpose_item<false>(w_out, D, D, WOUT, 0, scr, r, lane); continue; } r -= I_SQ;
        if (r < I_SQ) { p0_transpose_item<false>(wq, D, D, WQG, 0, scr, r, lane); continue; } r -= I_SQ;
        if (r < I_SQ) { p0_transpose_item<false>(ple_gate, D, D, WQG, D, scr, r, lane); continue; } r -= I_SQ;
        p0_transpose_item<false>(ple_proj, 256, D, WPP, 0, scr, r, lane);
    }
    cvt_copy(F, x, (bf16*)(F.ws + WS_XB), (size_t)T * D);
    cvt_copy(F, p, (bf16*)(F.ws + WS_PB), (size_t)T * 256);
    cvt_copy(F, subkeys, (bf16*)(F.ws + WS_SK), (size_t)8 * 2 * 128 * 128);
    { float* COS = (float*)(F.ws + WS_COS); float* SIN = (float*)(F.ws + WS_SIN);
      const int nthr = F.G * NWAVES * 64, gt = F.vcu * NWAVES * 64 + tid_();
      for (int e = gt; e < S * 64; e += nthr) { const int pos = e >> 6, i = e & 63;
          const float inv = 1.0f / powf(10000.0f, (float)(2 * i) * (1.0f / 128.0f));
          const float ang = (float)pos * inv; COS[e] = cosf(ang); SIN[e] = sinf(ang); } }
}
typedef float f32x16 __attribute__((ext_vector_type(16)));
typedef unsigned u32x2v __attribute__((ext_vector_type(2)));
__device__ __forceinline__ int crow(int r, int hi) { return (r & 3) + 8 * (r >> 2) + 4 * hi; }
__device__ __forceinline__ void attn_tile(const bf16* Qh, const bf16* Kh, const bf16* Vh, int R0, int Lsub, int maxd, bool isB, float sink,
                                          bf16* Orow0, int o_pitch, int o_tokstride  , float* MLrow0, int lane) {
    const int c = lane & 31, hi = lane >> 5;
    const int n0 = R0 & (Lsub - 1), rbase = R0 - n0;
    constexpr float C = 0.08838834764831845f * 1.4426950408889634f;
    bf16x8 qf[8];
#pragma unroll
    for (int s = 0; s < 8; ++s) qf[s] = *(const GAS bf16x8*)(Qh + (size_t)(R0 + c) * 128 + 16 * s + 8 * hi);
    f32x16 sc[5];
    const float NEG = -__builtin_inff();
#pragma unroll
    for (int kt = 0; kt < 5; ++kt) {
        const int nk = n0 - 128 + 32 * kt;
        if (nk >= 0) {
            const bf16* kp = Kh + (size_t)(rbase + nk + c) * 128 + 8 * hi;
            f32x16 a = {};
#pragma unroll
            for (int s = 0; s < 8; ++s) { const bf16x8 kf = *(const GAS bf16x8*)(kp + 16 * s); a = __builtin_amdgcn_mfma_f32_32x32x16_bf16(kf, qf[s], a, 0, 0, 0); }
            if (kt == 0) {
#pragma unroll
                for (int r = 0; r < 16; ++r) { const int dist = 128 + c - crow(r, hi); if (dist > maxd) a[r] = NEG; }
            }
            if (kt == 4) {
#pragma unroll
                for (int r = 0; r < 16; ++r) { if (crow(r, hi) > c) a[r] = NEG; }
            }
            sc[kt] = a;
        } else {
#pragma unroll
            for (int r = 0; r < 16; ++r) sc[kt][r] = NEG;
        }
    }
    float mx = NEG;
#pragma unroll
    for (int kt = 0; kt < 5; ++kt)
#pragma unroll
        for (int r = 0; r < 16; ++r) mx = fmaxf(mx, sc[kt][r]);
    mx = fmaxf(mx, __shfl_xor(mx, 32));
    float mt = mx * C;
    const float sink_t = sink * 1.4426950408889634f;
    if (isB) mt = fmaxf(mt, sink_t);
    float l = 0.f;
#pragma unroll
    for (int kt = 0; kt < 5; ++kt)
#pragma unroll
        for (int r = 0; r < 16; ++r) { const float pv = __builtin_amdgcn_exp2f(sc[kt][r] * C - mt); sc[kt][r] = pv; l += pv; }
    l += __shfl_xor(l, 32);
    const float denom = isB ? (l + __builtin_amdgcn_exp2f(sink_t - mt)) : l;
    const float inv = 1.0f / denom;
#pragma unroll
    for (int kt = 0; kt < 5; ++kt)
#pragma unroll
        for (int r = 0; r < 16; ++r) sc[kt][r] *= inv;
    f32x16 o[4];
#pragma unroll
    for (int e = 0; e < 4; ++e) o[e] = (f32x16){};
#pragma unroll
    for (int kt = 0; kt < 5; ++kt) {
        const int nk = n0 - 128 + 32 * kt;
        if (nk >= 0) {
            const bf16* vp = Vh + (size_t)(rbase + nk + 4 * hi) * 128 + 4 * c;
#pragma unroll
            for (int r = 0; r < 16; ++r) {
                const u32x2v vv = *(const GAS u32x2v*)(vp + (size_t)((r & 3) + 8 * (r >> 2)) * 128);
                const float pr = sc[kt][r];
                o[0] = __builtin_amdgcn_mfma_f32_32x32x2f32(pr, bf_lo_(vv.x), o[0], 0, 0, 0);
                o[1] = __builtin_amdgcn_mfma_f32_32x32x2f32(pr, bf_hi_(vv.x), o[1], 0, 0, 0);
                o[2] = __builtin_amdgcn_mfma_f32_32x32x2f32(pr, bf_lo_(vv.y), o[2], 0, 0, 0);
                o[3] = __builtin_amdgcn_mfma_f32_32x32x2f32(pr, bf_hi_(vv.y), o[3], 0, 0, 0);
            }
        }
    }
#pragma unroll
    for (int r = 0; r < 16; ++r) { const int q = crow(r, hi);
        u32x2v w; w.x = pk2(o[0][r], o[1][r]); w.y = pk2(o[2][r], o[3][r]);
        *(GAS u32x2v*)(Orow0 + (size_t)q * o_tokstride * o_pitch + 4 * c) = w; }
    if (!isB && hi == 0) { f32x2v ml; ml.x = mt; ml.y = l; *(GAS f32x2v*)(MLrow0 + (size_t)c * o_tokstride * 8) = ml; }
}
__device__ __forceinline__ void p2_attention(Frame& F, const float* sinks) {
    const bf16* QA = (const bf16*)(F.ws + WS_QA); const bf16* KA = (const bf16*)(F.ws + WS_KA); const bf16* VA = (const bf16*)(F.ws + WS_VA);
    const bf16* QB = (const bf16*)(F.ws + WS_QB); const bf16* KB = (const bf16*)(F.ws + WS_KB); const bf16* VB = (const bf16*)(F.ws + WS_VB);
    bf16* OG = (bf16*)(F.ws + WS_OG); bf16* OB = (bf16*)(F.ws + WS_OB); float* ML = (float*)(F.ws + WS_ML);
    const int gw = F.vcu * NWAVES + F.wave, NGW = F.G * NWAVES;
    constexpr int NTA = NB * 12 * 128, NTB = NB * 8 * 128, NTT = NTA + NTB;
    const int per = (NTT + NGW - 1) / NGW;
    for (int i = 0; i < per; ++i) {
        const int tile = gw * per + i; if (tile >= NTT) break;
        if (tile < NTA) {
            const int th = tile & 127, bj = tile >> 7, j = bj % 12, b = bj / 12, g = j >> 2, hh = j & 3, dsh = 2 * g, Lsub = S >> dsh, R0 = th * 32;
            const int res = R0 >> (12 - dsh), n0 = R0 & (Lsub - 1);
            const size_t hb = (size_t)(b * 12 + j) * S * 128;
            const size_t tok0 = (size_t)b * S + ((size_t)n0 << dsh) + res;
            attn_tile(QA + hb, KA + hb, VA + hb, R0, Lsub, 128, false, 0.f,
                      OG + ((size_t)g * T + tok0) * 512 + hh * 128, 512, 1 << dsh, ML + (((size_t)g * T + tok0) * 4 + hh) * 2, lane_());
        } else {
            const int t2 = tile - NTA, th = t2 & 127, bj = t2 >> 7, j = bj & 7, b = bj >> 3, R0 = th * 32;
            const size_t hq = (size_t)(b * 8 + j) * S * 128, hk = (size_t)(b * 2 + (j >> 2)) * S * 128;
            const size_t tok0 = (size_t)b * S + R0;
            attn_tile(QB + hq, KB + hk, VB + hk, R0, S, 127, true, sinks[j],
                      OB + tok0 * 1024 + j * 128, 1024, 1, nullptr, lane_());
        }
    }
}
__device__ __forceinline__ void p3_combine(Frame& F, const float* peer_u, const float* peer_v) {
    const bf16* OG = (const bf16*)(F.ws + WS_OG); const float* ML = (const float*)(F.ws + WS_ML); bf16* OA = (bf16*)(F.ws + WS_OA);
    const int gw = F.vcu * NWAVES + F.wave, NGW = F.G * NWAVES, lane = lane_();
    const int hh = lane >> 4;
    for (int tok = gw; tok < T; tok += NGW) {
        float m[3], l[3];
#pragma unroll
        for (int g = 0; g < 3; ++g) { const f32x2v v = *(const GAS f32x2v*)(ML + (((size_t)g * T + tok) * 4 + hh) * 2); m[g] = v.x; l[g] = v.y; }
        const float M = fmaxf(fmaxf(m[0], m[1]), m[2]);
        float w[3], ws = 0.f;
#pragma unroll
        for (int g = 0; g < 3; ++g) { w[g] = l[g] * __builtin_amdgcn_exp2f(m[g] - M); ws += w[g]; }
        const float iw = 1.0f / ws;
        f32x4 a0 = {0.f, 0.f, 0.f, 0.f}, a1 = {0.f, 0.f, 0.f, 0.f};
#pragma unroll
        for (int g = 0; g < 3; ++g) { const v4u v = *(const GAS v4u*)(OG + ((size_t)g * T + tok) * 512 + lane * 8); const float wg = w[g] * iw;
            a0 += wg * (f32x4){bf_lo_(v.x), bf_hi_(v.x), bf_lo_(v.y), bf_hi_(v.y)}; a1 += wg * (f32x4){bf_lo_(v.z), bf_hi_(v.z), bf_lo_(v.w), bf_hi_(v.w)}; }
        v4u o; o.x = pk2(a0.x, a0.y); o.y = pk2(a0.z, a0.w); o.z = pk2(a1.x, a1.y); o.w = pk2(a1.z, a1.w);
        *(GAS v4u*)(OA + (size_t)tok * 512 + lane * 8) = o;
    }
    cvt_copy(F, peer_u, (bf16*)(F.ws + WS_UB), (size_t)16384 * 2048);
    cvt_copy(F, peer_v, (bf16*)(F.ws + WS_VT), (size_t)16384 * 2048);
}
__device__ __forceinline__ void p7_ln1(Frame& F, const float* ln1_g, const float* ln1_b) {
    float* H1 = (float*)(F.ws + WS_H1); bf16* H1B = (bf16*)(F.ws + WS_H1B);
    const int gw = F.vcu * NWAVES + F.wave, NGW = F.G * NWAVES, lane = lane_();
    for (int m = gw; m < T; m += NGW) {
        GAS f32x4* xr = (GAS f32x4*)(H1 + (size_t)m * D) + lane;
        f32x4 v[8]; float s = 0.f;
#pragma unroll
        for (int j = 0; j < 8; ++j) { v[j] = xr[64 * j]; s += (v[j].x + v[j].y) + (v[j].z + v[j].w); }
        const float mean = wave_sum(s) * (1.f / D); float s2 = 0.f;
#pragma unroll
        for (int j = 0; j < 8; ++j) { v[j] = v[j] - mean; s2 += (v[j].x * v[j].x + v[j].y * v[j].y) + (v[j].z * v[j].z + v[j].w * v[j].w); }
        const float rstd = 1.f / sqrtf(wave_sum(s2) * (1.f / D) + LN_EPS);
        GAS unsigned long long* o8 = (GAS unsigned long long*)(H1B + (size_t)m * D) + lane;
#pragma unroll
        for (int j = 0; j < 8; ++j) { const f32x4 gvj = *((const GAS f32x4*)ln1_g + lane + 64 * j), bvj = *((const GAS f32x4*)ln1_b + lane + 64 * j);
            const f32x4 y = v[j] * rstd * gvj + bvj; xr[64 * j] = y;
            o8[64 * j] = (unsigned long long)pk2(y.x, y.y) | ((unsigned long long)pk2(y.z, y.w) << 32); }
    }
}
__device__ __forceinline__ unsigned f2ord(float f) { const unsigned u = __builtin_bit_cast(unsigned, f); return (u & 0x80000000u) ? ~u : (u | 0x80000000u); }
__device__ __forceinline__ float ord2f(unsigned o) { const unsigned u = (o & 0x80000000u) ? (o ^ 0x80000000u) : ~o; return __builtin_bit_cast(float, u); }
__device__ __forceinline__ unsigned umax_(unsigned a, unsigned b) { return a > b ? a : b; }
__device__ __forceinline__ unsigned umin_(unsigned a, unsigned b) { return a < b ? a : b; }
template <int N> __device__ __forceinline__ void bitonic_sort_desc(unsigned (&v)[N]) {
#pragma unroll
    for (int k = 2; k <= N; k <<= 1)
#pragma unroll
        for (int j = k >> 1; j > 0; j >>= 1)
#pragma unroll
            for (int i = 0; i < N; ++i) { const int l = i ^ j;
                if (l > i) { const unsigned a = v[i], b = v[l], mx = umax_(a, b), mn = umin_(a, b); const bool desc = ((i & k) == 0); v[i] = desc ? mx : mn; v[l] = desc ? mn : mx; } }
}
template <int N> __device__ __forceinline__ void bitonic_merge_desc(unsigned (&v)[N]) {
#pragma unroll
    for (int j = N >> 1; j > 0; j >>= 1)
#pragma unroll
        for (int i = 0; i < N; ++i) { const int l = i ^ j;
            if (l > i) { const unsigned a = v[i], b = v[l]; v[i] = umax_(a, b); v[l] = umin_(a, b); } }
}
__host__ __device__ constexpr int cand_ok(int i, int j) { return (i + 1) * (j + 1) <= 16; }
__host__ __device__ constexpr int cand_index(int i, int j) { int n = 0; for (int a = 0; a < 16; ++a) for (int b = 0; b < 16; ++b) { if (a == i && b == j) return n; if (cand_ok(a, b)) ++n; } return n; }
__device__ __forceinline__ void route_half(const bf16* Q, const bf16* SK, int tok0, int h, int c, int lane, unsigned (&top)[16]) {
    const int cl = lane & 31, hi = lane >> 5;
    bf16x8 qf[8];
#pragma unroll
    for (int s = 0; s < 8; ++s) qf[s] = *(const GAS bf16x8*)(Q + (size_t)(tok0 + cl) * 2048 + h * 256 + c * 128 + 16 * s + 8 * hi);
    unsigned v[64];
#pragma unroll
    for (int nt = 0; nt < 4; ++nt) {
        const bf16* kp = SK + (size_t)((h * 2 + c) * 128 + nt * 32 + cl) * 128 + 8 * hi;
        f32x16 a = {};
#pragma unroll
        for (int s = 0; s < 8; ++s) { const bf16x8 kf = *(const GAS bf16x8*)(kp + 16 * s); a = __builtin_amdgcn_mfma_f32_32x32x16_bf16(kf, qf[s], a, 0, 0, 0); }
#pragma unroll
        for (int r = 0; r < 16; ++r) { const int n = nt * 32 + crow(r, hi); v[nt * 16 + r] = (f2ord(a[r]) & ~127u) | (unsigned)(127 - n); }
        asm volatile("" ::: "memory");
    }
    bitonic_sort_desc<64>(v);
    unsigned w[16];
#pragma unroll
    for (int i = 0; i < 16; ++i) { const unsigned pv = (unsigned)__shfl_xor((int)v[15 - i], 32); w[i] = umax_(v[i], pv); }
    bitonic_merge_desc<16>(w);
#pragma unroll
    for (int i = 0; i < 16; ++i) top[i] = w[i];
}
__device__ __forceinline__ void p9_route(Frame& F) {
    const bf16* Q = (const bf16*)(F.ws + WS_Q); const bf16* SK = (const bf16*)(F.ws + WS_SK);
    int* IDX = (int*)(F.ws + WS_IDX); float* GATE = (float*)(F.ws + WS_GATE);
    const int gw = F.vcu * NWAVES + F.wave, NGW = F.G * NWAVES;
    LAS unsigned* sidx = (LAS unsigned*)(F.lds + RING_OFF + F.wave * 8192);
    constexpr int NUNIT = (T / 32) * 8;
    for (int unit = gw; unit < NUNIT; unit += NGW) {
        int lane = lane_(); asm volatile("" : "+v"(lane)); const int cl = lane & 31, hi = lane >> 5;
        const int tt = unit >> 3, h = unit & 7, tok0 = tt * 32;
        unsigned k1[16], k2[16];
        route_half(Q, SK, tok0, h, 0, lane, k1);
        route_half(Q, SK, tok0, h, 1, lane, k2);
        float s1[16], s2[16];
#pragma unroll
        for (int i = 0; i < 16; ++i) { s1[i] = ord2f(k1[i] & ~127u); s2[i] = ord2f(k2[i] & ~127u);
            sidx[(0 * 16 + i) * 64 + lane] = 127u - (k1[i] & 127u); sidx[(1 * 16 + i) * 64 + lane] = 127u - (k2[i] & 127u); }
        unsigned cd[64];
#pragma unroll
        for (int i = 0; i < 64; ++i) cd[i] = 0u;
        constexpr int CN[16] = {16, 8, 5, 4, 3, 2, 2, 2, 1, 1, 1, 1, 1, 1, 1, 1};
        constexpr int CO[16] = {0, 16, 24, 29, 33, 36, 38, 40, 42, 43, 44, 45, 46, 47, 48, 49};
#pragma unroll
        for (int i = 0; i < 16; ++i)
#pragma unroll
            for (int j = 0; j < 16; ++j) if (j < CN[i]) cd[CO[i] + j] = (f2ord(s1[i] + s2[j]) & ~255u) | (unsigned)(255 - (i * 16 + j));
        bitonic_sort_desc<64>(cd);
        float fs[16]; float es = 0.f;
#pragma unroll
        for (int k = 0; k < 16; ++k) fs[k] = ord2f(cd[k] & ~255u);
        const float fm = fs[0];
#pragma unroll
        for (int k = 0; k < 16; ++k) { fs[k] = __expf(fs[k] - fm); es += fs[k]; }
        const float ies = 1.0f / es;
        int ex[16];
#pragma unroll
        for (int k = 0; k < 16; ++k) { const unsigned code = 255u - (cd[k] & 255u); const unsigned e1 = sidx[(0 * 16 + (code >> 4)) * 64 + lane], e2 = sidx[(1 * 16 + (code & 15u)) * 64 + lane];
            ex[k] = (int)(e1 * 128u + e2); fs[k] *= ies; }
        if (hi == 0) {
            GAS int* ip = (GAS int*)(IDX + (size_t)(tok0 + cl) * 128 + h * 16); GAS float* gp = (GAS float*)(GATE + (size_t)(tok0 + cl) * 128 + h * 16);
#pragma unroll
            for (int k = 0; k < 16; k += 4) { *(GAS i32x4*)(ip + k) = (i32x4){ex[k], ex[k + 1], ex[k + 2], ex[k + 3]}; *(GAS f32x4*)(gp + k) = (f32x4){fs[k], fs[k + 1], fs[k + 2], fs[k + 3]}; }
        }
    }
}
__device__ __forceinline__ float dot2_bf16(unsigned w, unsigned x, float acc) { return __builtin_amdgcn_fdot2_f32_bf16(__builtin_bit_cast(bf16x2_t, w), __builtin_bit_cast(bf16x2_t, x), acc, false); }
__device__ __forceinline__ float gelu_erf(float x) { return 0.5f * x * (1.0f + erff(x * 0.70710678118654752f)); }
__device__ __forceinline__ void glds16(const void* gsrc, unsigned lds_dst) { unsigned keep;
    asm volatile("s_mov_b32 %0, m0\n\ts_mov_b32 m0, %2\n\ts_nop 0\n\tglobal_load_lds_dwordx4 %1, off\n\ts_mov_b32 m0, %0" : "=&s"(keep) : "v"(gsrc), "s"(lds_dst) : "memory"); }
__device__ __forceinline__ void p10_gather(Frame& F, const float* ln2_g, const float* ln2_b, float* out) {
    const float* H1 = (const float*)(F.ws + WS_H1); const bf16* H1B = (const bf16*)(F.ws + WS_H1B); const bf16* PLE = (const bf16*)(F.ws + WS_PP);
    const unsigned char* UB = (const unsigned char*)(F.ws + WS_UB); const unsigned char* VT = (const unsigned char*)(F.ws + WS_VT);
    const int* IDX = (const int*)(F.ws + WS_IDX); const float* GATE = (const float*)(F.ws + WS_GATE);
    const int gw = F.vcu * NWAVES + F.wave, NGW = F.G * NWAVES;
    const int per = (T + NGW - 1) / NGW;
    const unsigned ring = (unsigned)(uintptr_t)(F.lds + RING_OFF) + (unsigned)F.wave * 16384u;
    for (int ti = 0; ti < per; ++ti) {
        const int tok = gw * per + ti; if (tok >= T) break;
        int lane = lane_(); asm volatile("" : "+v"(lane));
        const int id0 = IDX[(size_t)tok * 128 + lane], id1 = IDX[(size_t)tok * 128 + 64 + lane];
        const float g0 = GATE[(size_t)tok * 128 + lane], g1 = GATE[(size_t)tok * 128 + 64 + lane];
        v4u hb[4];
#pragma unroll
        for (int c = 0; c < 4; ++c) hb[c] = *(const GAS v4u*)(H1B + (size_t)tok * D + c * 512 + lane * 8);
        float acc[32];
#pragma unroll
        for (int i = 0; i < 32; ++i) acc[i] = 0.f;
        const LAS v4u* rd = (const LAS v4u*)(F.lds + RING_OFF + F.wave * 16384) + lane;
        const unsigned lane16 = (unsigned)lane * 16u;
#define ROW_DMA(hx, q) do { const int hx_ = (hx) > 7 ? 7 : (hx); const int e_ = __builtin_amdgcn_readlane((hx_ < 4) ? id0 : id1, (hx_ & 3) * 16 + ((q) & 15)); \
            const unsigned char* src_ = (((q) & 16) ? VT : UB) + (size_t)e_ * 4096 + lane16; const unsigned dst_ = ring + (unsigned)(((q) & 3) * 4096); \
            glds16(src_, dst_); glds16(src_ + 1024, dst_ + 1024u); glds16(src_ + 2048, dst_ + 2048u); glds16(src_ + 3072, dst_ + 3072u); } while (0)
        asm volatile("s_waitcnt vmcnt(0)" ::: "memory");
        ROW_DMA(0, 0); ROW_DMA(0, 1); ROW_DMA(0, 2);
        for (int hd = 0; hd < 8; ++hd) {
            const float gsel = (hd < 4) ? g0 : g1; const int lbase = (hd & 3) * 16;
            float part[16]; float wv = 0.f;
#pragma unroll
            for (int q = 0; q < 32; ++q) {
                if (q + 3 < 32) ROW_DMA(hd, q + 3); else ROW_DMA(hd + 1, q + 3 - 32);
                asm volatile("s_waitcnt vmcnt(12)" ::: "memory");
                const v4u r0 = rd[(q & 3) * 256], r1 = rd[(q & 3) * 256 + 64], r2 = rd[(q & 3) * 256 + 128], r3 = rd[(q & 3) * 256 + 192];
                asm volatile("s_waitcnt lgkmcnt(0)" ::: "memory");
                if (q < 16) {
                    float a0 = 0.f, a1 = 0.f;
                    a0 = dot2_bf16(r0.x, hb[0].x, a0); a1 = dot2_bf16(r0.y, hb[0].y, a1); a0 = dot2_bf16(r0.z, hb[0].z, a0); a1 = dot2_bf16(r0.w, hb[0].w, a1);
                    a0 = dot2_bf16(r1.x, hb[1].x, a0); a1 = dot2_bf16(r1.y, hb[1].y, a1); a0 = dot2_bf16(r1.z, hb[1].z, a0); a1 = dot2_bf16(r1.w, hb[1].w, a1);
                    a0 = dot2_bf16(r2.x, hb[2].x, a0); a1 = dot2_bf16(r2.y, hb[2].y, a1); a0 = dot2_bf16(r2.z, hb[2].z, a0); a1 = dot2_bf16(r2.w, hb[2].w, a1);
                    a0 = dot2_bf16(r3.x, hb[3].x, a0); a1 = dot2_bf16(r3.y, hb[3].y, a1); a0 = dot2_bf16(r3.z, hb[3].z, a0); a1 = dot2_bf16(r3.w, hb[3].w, a1);
                    part[q & 15] = a0 + a1;
                    if (q == 15) {
#pragma unroll
                        for (int st = 8; st >= 1; st >>= 1) { const bool up_ = (lane & st) != 0;
#pragma unroll
                            for (int i = 0; i < st; ++i) { const float send = up_ ? part[i] : part[i + st], keep = up_ ? part[i + st] : part[i]; part[i] = keep + __shfl_xor(send, st); } }
                        float tot = part[0]; tot += __shfl_xor(tot, 16); tot += __shfl_xor(tot, 32);
                        const float gk = __shfl(gsel, lbase + (lane & 15));
                        wv = gk * gelu_erf(tot);
                    }
                } else {
                    const float wk = __builtin_bit_cast(float, __builtin_amdgcn_readlane(__builtin_bit_cast(int, wv), q & 15));
                    const v4u rr[4] = {r0, r1, r2, r3};
#pragma unroll
                    for (int c = 0; c < 4; ++c) { const v4u v = rr[c];
                        acc[c * 8 + 0] += wk * bf_lo_(v.x); acc[c * 8 + 1] += wk * bf_hi_(v.x); acc[c * 8 + 2] += wk * bf_lo_(v.y); acc[c * 8 + 3] += wk * bf_hi_(v.y);
                        acc[c * 8 + 4] += wk * bf_lo_(v.z); acc[c * 8 + 5] += wk * bf_hi_(v.z); acc[c * 8 + 6] += wk * bf_lo_(v.w); acc[c * 8 + 7] += wk * bf_hi_(v.w);
                        asm volatile("" : "+v"(acc[c * 8 + 0]), "+v"(acc[c * 8 + 1]), "+v"(acc[c * 8 + 2]), "+v"(acc[c * 8 + 3]), "+v"(acc[c * 8 + 4]), "+v"(acc[c * 8 + 5]), "+v"(acc[c * 8 + 6]), "+v"(acc[c * 8 + 7])); }
                }
            }
        }
#undef ROW_DMA
        asm volatile("s_waitcnt vmcnt(0)" ::: "memory");
        float s = 0.f;
#pragma unroll
        for (int c = 0; c < 4; ++c) { const size_t off = (size_t)tok * D + c * 512 + lane * 8;
            const f32x4 h0 = *(const GAS f32x4*)(H1 + off), h1v = *(const GAS f32x4*)(H1 + off + 4); const v4u pv = *(const GAS v4u*)(PLE + off);
            acc[c * 8 + 0] += DN_ALPHA * h0.x + bf_lo_(pv.x); acc[c * 8 + 1] += DN_ALPHA * h0.y + bf_hi_(pv.x); acc[c * 8 + 2] += DN_ALPHA * h0.z + bf_lo_(pv.y); acc[c * 8 + 3] += DN_ALPHA * h0.w + bf_hi_(pv.y);
            acc[c * 8 + 4] += DN_ALPHA * h1v.x + bf_lo_(pv.z); acc[c * 8 + 5] += DN_ALPHA * h1v.y + bf_hi_(pv.z); acc[c * 8 + 6] += DN_ALPHA * h1v.z + bf_lo_(pv.w); acc[c * 8 + 7] += DN_ALPHA * h1v.w + bf_hi_(pv.w); }
#pragma unroll
        for (int i = 0; i < 32; ++i) s += acc[i];
        const float mean = wave_sum(s) * (1.f / D); float s2 = 0.f;
#pragma unroll
        for (int i = 0; i < 32; ++i) { acc[i] -= mean; s2 += acc[i] * acc[i]; }
        const float rstd = 1.f / sqrtf(wave_sum(s2) * (1.f / D) + LN_EPS);
#pragma unroll
        for (int c = 0; c < 4; ++c) { const int col = c * 512 + lane * 8; const size_t off = (size_t)tok * D + col;
            const f32x4 ga = *(const GAS f32x4*)(ln2_g + col), gb = *(const GAS f32x4*)(ln2_g + col + 4), ba = *(const GAS f32x4*)(ln2_b + col), bb = *(const GAS f32x4*)(ln2_b + col + 4);
            f32x4 o0, o1;
            o0.x = acc[c * 8 + 0] * rstd * ga.x + ba.x; o0.y = acc[c * 8 + 1] * rstd * ga.y + ba.y; o0.z = acc[c * 8 + 2] * rstd * ga.z + ba.z; o0.w = acc[c * 8 + 3] * rstd * ga.w + ba.w;
            o1.x = acc[c * 8 + 4] * rstd * gb.x + bb.x; o1.y = acc[c * 8 + 5] * rstd * gb.y + bb.y; o1.z = acc[c * 8 + 6] * rstd * gb.z + bb.z; o1.w = acc[c * 8 + 7] * rstd * gb.w + bb.w;
            *(GAS f32x4*)(out + off) = o0; *(GAS f32x4*)(out + off + 4) = o1; }
    }
}
struct Args { const float* in[17]; float* out; unsigned char* ws; int ph_lo, ph_hi, li, pad; };
template <int BYTE_OFF> __device__ __forceinline__ const float* karg_ptr() {
    auto kp = __builtin_amdgcn_kernarg_segment_ptr(); unsigned long long v;
    asm volatile("s_load_dwordx2 %0, %1, %2\n\ts_waitcnt lgkmcnt(0)" : "=s"(v) : "s"(kp), "i"(BYTE_OFF) : "memory");
    return (const float*)v;
}
#define KIN(k) karg_ptr<8 * (k)>()
__global__ void __launch_bounds__(NWAVES * 64, 2) mk_fwd(Args args) {
    extern __shared__ __attribute__((aligned(16))) unsigned char lds[];
    Frame F;
    F.lds = (LAS unsigned char*)lds;
    F.MISC = (volatile LAS unsigned*)(F.lds + MISC_OFF);
    F.wave = __builtin_amdgcn_readfirstlane((int)(threadIdx.x >> 6));
    F.G = gridDim.x; { const int bx = blockIdx.x; F.vcu = (F.G % 8 == 0) ? (bx % 8) * (F.G / 8) + bx / 8 : bx; }
    unsigned char* ws = args.ws; F.ws = ws;
    F.ctl = (gu32*)(ws + WS_CTL);
    for (int u = tid_(); u < (LDS_BYTES - LDSCTL_OFF) / 4; u += NWAVES * 64) ((LAS unsigned*)(F.lds + LDSCTL_OFF))[u] = 0u;
    __syncthreads();
    XcdBarrier bar; bar.bar = (unsigned*)(F.ctl + CW_BAR); bar.x = 0; bar.st = nullptr;
    if (N_LAUNCHES == 1) bar = xcd_barrier_post((unsigned*)(F.ctl + CW_BAR), F.MISC + 8);
#define GRID_BAR() do { if (N_LAUNCHES == 1) xcd_barrier(bar); } while (0)
    const int lo = args.ph_lo, hi = args.ph_hi;
#define IN(k) (lo <= (k) && (k) < hi)
#define BOTH(k) (IN(k) && IN((k) + 1))
    bf16* const WIN = (bf16*)(ws + WS_WIN); bf16* const XB = (bf16*)(ws + WS_XB); bf16* const G = (bf16*)(ws + WS_G);

    if (IN(0)) { p0_prologue(F, KIN(0), KIN(1), KIN(2), KIN(4), KIN(5), KIN(6), KIN(9), KIN(10), KIN(13), KIN(14)); if (BOTH(0)) GRID_BAR(); }

    if (IN(1)) {
        pg8::Gemm g{XB, WIN, T, IN_COLS, D}; pg8::StaticOrder So; So.init(T, IN_COLS, F.G, (int)blockIdx.x);
        pg8::EpiQKV E{(bf16*)(ws + WS_QA), (bf16*)(ws + WS_KA), (bf16*)(ws + WS_VA), (bf16*)(ws + WS_QB), (bf16*)(ws + WS_KB), (bf16*)(ws + WS_VB), G, (const float*)(ws + WS_COS), (const float*)(ws + WS_SIN)};
        pg8::gemm_phase<pg8::EpiQKV, pg8::StaticOrder, true, true>(F.lds + RING_OFF, g, So, E);
        if (BOTH(1)) GRID_BAR();
    }
    if (IN(2)) { p2_attention(F, KIN(3)); if (BOTH(2)) GRID_BAR(); }
    if (IN(3)) { p3_combine(F, KIN(11), KIN(12)); if (BOTH(3)) GRID_BAR(); }
    if (IN(4)) {
        pg8::Gemm g{(const bf16*)(ws + WS_OA), (const bf16*)(ws + WS_WBA), T, D, 512}; pg8::StaticOrder So; So.init(T, D, F.G, (int)blockIdx.x);
        pg8::EpiBranchA E{G};
        pg8::gemm_phase<pg8::EpiBranchA, pg8::StaticOrder, true, true>(F.lds + RING_OFF, g, So, E);
        if (BOTH(4)) GRID_BAR();
    }
    if (IN(5)) {
        pg8::Gemm g{(const bf16*)(ws + WS_OB), (const bf16*)(ws + WS_WBB), T, D, 1024}; pg8::StaticOrder So; So.init(T, D, F.G, (int)blockIdx.x);
        pg8::EpiBranchB E{G, (bf16*)(ws + WS_MERGED)};
        pg8::gemm_phase<pg8::EpiBranchB, pg8::StaticOrder, true, true>(F.lds + RING_OFF, g, So, E);
        if (BOTH(5)) GRID_BAR();
    }
    if (IN(6)) {
        pg8::Gemm g{(const bf16*)(ws + WS_MERGED), (const bf16*)(ws + WS_WOUT), T, D, D}; pg8::StaticOrder So; So.init(T, D, F.G, (int)blockIdx.x);
        pg8::EpiWout E{KIN(0), (float*)(ws + WS_H1), DN_ALPHA};
        pg8::gemm_phase<pg8::EpiWout, pg8::StaticOrder, true, true>(F.lds + RING_OFF, g, So, E);
        if (BOTH(6)) GRID_BAR();
    }
    if (IN(7)) {
        p7_ln1(F, KIN(7), KIN(8));
        int kpp = 256; asm volatile("" : "+s"(kpp));
        pg8::Gemm g{(const bf16*)(ws + WS_PB), (const bf16*)(ws + WS_WPP), T, D, kpp}; pg8::StaticOrder So; So.init(T, D, F.G, (int)blockIdx.x);
        pg8::EpiPlain E{(bf16*)(ws + WS_PP), D};
        pg8::gemm_phase<pg8::EpiPlain, pg8::StaticOrder, true, true>(F.lds + RING_OFF, g, So, E);
        if (BOTH(7)) GRID_BAR();
    }
    if (IN(8)) {
        pg8::Gemm g{(const bf16*)(ws + WS_H1B), (const bf16*)(ws + WS_WQG), T, NQG, D}; pg8::StaticOrder So; So.init(T, NQG, F.G, (int)blockIdx.x);
        pg8::EpiQG E{(bf16*)(ws + WS_Q), (bf16*)(ws + WS_PP)};
        pg8::gemm_phase<pg8::EpiQG, pg8::StaticOrder, true, true>(F.lds + RING_OFF, g, So, E);
        if (BOTH(8)) GRID_BAR();
    }
    if (IN(9)) { p9_route(F); if (BOTH(9)) GRID_BAR(); }
    if (IN(10)) { p10_gather(F, KIN(15), KIN(16), (float*)KIN(17)); }
#undef IN
#undef BOTH
}

extern "C" void kernel_launch(void* const* d_in, const int* in_sizes, int n_in, void* d_out, int out_size, void* d_ws, size_t ws_size, hipStream_t stream) {
    static int grid = 0;
    if (grid == 0) {
        if (n_in != 17 || in_sizes[0] != T * D || out_size != T * D || ws_size < WS_END) { fprintf(stderr, "kernel_launch: unexpected shapes (n_in %d, in0 %d, out %d, ws %zu); nothing launched\n", n_in, n_in > 0 ? in_sizes[0] : -1, out_size, ws_size); grid = -1; return; }
        int dev = 0, cus = 0, per_cu = 0;
        if (hipGetDevice(&dev) != hipSuccess || hipDeviceGetAttribute(&cus, hipDeviceAttributeMultiprocessorCount, dev) != hipSuccess) { grid = -1; return; }
        if (hipFuncSetAttribute((const void*)mk_fwd, hipFuncAttributeMaxDynamicSharedMemorySize, LDS_BYTES) != hipSuccess) { fprintf(stderr, "kernel_launch: hipFuncSetAttribute failed\n"); grid = -1; return; }
        if (hipOccupancyMaxActiveBlocksPerMultiprocessor(&per_cu, (const void*)mk_fwd, NWAVES * 64, LDS_BYTES) != hipSuccess || per_cu < 1)
            fprintf(stderr, "kernel_launch: note: occupancy query reports %d workgroups per CU\n", per_cu);
        (void)hipGetLastError();
        grid = cus;
    }
    if (grid < 0) return;
    if (N_LAUNCHES == 1) { if (hipMemsetAsync((char*)d_ws + WS_CTL, 0, CTL_ZERO_BYTES, stream) != hipSuccess) { fprintf(stderr, "kernel_launch: hipMemsetAsync failed\n"); return; } }
    Args a{};
    for (int i = 0; i < 17; ++i) a.in[i] = (const float*)d_in[i];
    a.out = (float*)d_out; a.ws = (unsigned char*)d_ws;
    for (int li = 0; li < N_LAUNCHES; ++li) {
        a.ph_lo = (N_LAUNCHES == 1) ? 0 : li; a.ph_hi = (N_LAUNCHES == 1) ? NPHASES : li + 1; a.li = li;
        hipLaunchKernelGGL(mk_fwd, dim3(grid), dim3(NWAVES * 64), LDS_BYTES, stream, a);
        const hipError_t le = hipPeekAtLastError();
        if (le != hipSuccess) { fprintf(stderr, "kernel_launch: launch %d failed: %s\n", li, hipGetErrorName(le)); break; }
    }
}
```

```cpp
#include <hip/hip_runtime.h>
#include <cstdio>
#include <cstdint>
#define CVT2_FP8(a_, b_, old_, sel_) __builtin_amdgcn_cvt_pk_fp8_f32(__builtin_amdgcn_fmed3f((a_), -448.0f, 448.0f), __builtin_amdgcn_fmed3f((b_), -448.0f, 448.0f), (old_), (sel_))
namespace pg8 {
#define PG8_LAS __attribute__((address_space(3)))
typedef unsigned short bf16_t;
typedef short bf16x8 __attribute__((ext_vector_type(8)));
typedef float f32x4 __attribute__((ext_vector_type(4)));
typedef unsigned u32x4 __attribute__((ext_vector_type(4)));
constexpr int BM = 256, BK = 64, HALF = 128, HTB = HALF * BK * 2  , STAGE_BYTES = 8 * HTB, NXCD = 8, WGM = 8;

__host__ __device__ __forceinline__ int lds_byte(int r, int c) { const int st = (r >> 4) * 2 + (c >> 5), rr = r & 15, cc = c & 31, ob = rr * 64 + cc * 2; return st * 1024 + (ob ^ (((ob >> 9) & 1) << 5)); }
__host__ __device__ __forceinline__ void stage_rc(int b, int& R, int& C) { const int st = b / 1024, sb = b % 1024, swz = sb ^ (((sb >> 9) & 1) << 5); R = (st >> 1) * 16 + swz / 64; C = (st & 1) * 32 + (swz % 64) / 2; }
__host__ __device__ __forceinline__ int perm32(int rho) { const int n = rho >> 4, i = rho & 15; return 8 * (i >> 2) + 4 * n + (i & 3); }

struct Unit { int pm, pn; };
struct Gemm { const bf16_t* A; const bf16_t* Bt; int M, N, K; };

struct StaticOrder {
    int nM, nN, nwg, G, c, wg;
    __host__ __device__ void init(int M, int N, int G_, int c_, int wg_ = WGM) { nM = M / BM; nN = N / BM; nwg = nM * nN; G = G_; c = c_; wg = wg_; }
    __host__ __device__ bool next(int i, Unit& u) const {
        const long L = (long)i * G + c; if (L >= nwg) return false;
        int wgid = (int)L; { const int q = nwg / NXCD, r = nwg % NXCD, xcd = wgid % NXCD, off = wgid / NXCD; wgid = (xcd < r ? xcd * (q + 1) : r * (q + 1) + (xcd - r) * q) + off; }
        const int nig = wg * nN, gid = wgid / nig, fm = gid * wg, gsz = (nM - fm) < wg ? (nM - fm) : wg;
        u.pm = fm + ((wgid % nig) % gsz); u.pn = (wgid % nig) / gsz; return true;
    }
    __device__ __forceinline__ void a_ready(const Unit&) const {}
    __device__ __forceinline__ void done(const Unit&) const {}
};

typedef float f32x2_t __attribute__((ext_vector_type(2))); typedef __bf16 bf16x2_t __attribute__((ext_vector_type(2)));
__device__ __forceinline__ unsigned cvt_pk_bf16(float lo, float hi) { const f32x2_t v = {lo, hi}; const bf16x2_t b = __builtin_convertvector(v, bf16x2_t); return __builtin_bit_cast(unsigned, b); }
typedef unsigned u32x2 __attribute__((ext_vector_type(2)));
__device__ __forceinline__ float bf_lo(unsigned w) { return __builtin_bit_cast(float, w << 16); }
__device__ __forceinline__ float bf_hi(unsigned w) { return __builtin_bit_cast(float, w & 0xffff0000u); }
__device__ __forceinline__ float sigmoidf_(float x) { return __builtin_amdgcn_rcpf(1.0f + __builtin_amdgcn_exp2f(-1.4426950408889634f * x)); }
__device__ __forceinline__ u32x4 pack8(f32x4 a, f32x4 b) { u32x4 w; w.x = cvt_pk_bf16(a[0], a[1]); w.y = cvt_pk_bf16(a[2], a[3]); w.z = cvt_pk_bf16(b[0], b[1]); w.w = cvt_pk_bf16(b[2], b[3]); return w; }
__device__ __forceinline__ void unpack8(u32x4 w, f32x4& a, f32x4& b) { a = (f32x4){bf_lo(w.x), bf_hi(w.x), bf_lo(w.y), bf_hi(w.y)}; b = (f32x4){bf_lo(w.z), bf_hi(w.z), bf_lo(w.w), bf_hi(w.w)}; }

struct EpiQKV {
    static constexpr bool PERM = true, AFTER_DRAIN = false;
    bf16_t *QA, *KA, *VA, *QB, *KB, *VB, *G; const float *COS, *SIN; float zs;
    __device__ __forceinline__ void operator()(const f32x4 (&acc)[2][2][4][2], const Unit& u, int wr, int wc, int fr, int fq) const {
        const int pn = u.pn; const int row0 = u.pm * BM + wr * 64 + fr;
        if (pn >= 24) {
            const int col0 = (pn - 24) * 256 + wc * 32 + 8 * fq;
#pragma unroll
            for (int ai = 0; ai < 2; ++ai)
#pragma unroll
                for (int m = 0; m < 4; ++m) { bf16_t* rowp = G + (size_t)(row0 + ai * HALF + m * 16) * 4096 + col0;
#pragma unroll
                    for (int bj = 0; bj < 2; ++bj) { f32x4 v0 = acc[ai][bj][m][0] * zs, v1 = acc[ai][bj][m][1] * zs;
#pragma unroll
                        for (int i = 0; i < 4; ++i) { v0[i] = sigmoidf_(v0[i]); v1[i] = sigmoidf_(v1[i]); }
                        *(u32x4*)(rowp + bj * HALF) = pack8(v0, v1); } }
        } else {
            bf16_t* base; int nh, j0; bool rope;
            if (pn < 6) { base = QA; nh = 12; j0 = 2 * pn; rope = true; }
            else if (pn < 12) { base = KA; nh = 12; j0 = 2 * (pn - 6); rope = true; }
            else if (pn < 18) { base = VA; nh = 12; j0 = 2 * (pn - 12); rope = false; }
            else if (pn < 22) { base = QB; nh = 8; j0 = 2 * (pn - 18); rope = true; }
            else if (pn == 22) { base = KB; nh = 2; j0 = 0; rope = true; }
            else { base = VB; nh = 2; j0 = 0; rope = false; }
            const int dsh = (nh == 12) ? 2 * (j0 >> 2) : 0;
            if (rope) {
                const int i0 = 16 * wc + 4 * fq;
#pragma unroll
                for (int ai = 0; ai < 2; ++ai)
#pragma unroll
                    for (int m = 0; m < 4; ++m) { const int row = row0 + ai * HALF + m * 16, b = row >> 12, s = row & 4095;
                        const int rih = ((s & ((1 << dsh) - 1)) << (12 - dsh)) + (s >> dsh);
                        const f32x4 c4 = *(const f32x4*)(COS + s * 64 + i0), s4 = *(const f32x4*)(SIN + s * 64 + i0);
#pragma unroll
                        for (int bj = 0; bj < 2; ++bj) { bf16_t* dst = base + ((size_t)(b * nh + j0 + bj) * 4096 + rih) * 128 + i0;
                            const f32x4 v0 = acc[ai][bj][m][0] * zs, v1 = acc[ai][bj][m][1] * zs;
                            const f32x4 o1 = v0 * c4 - v1 * s4, o2 = v0 * s4 + v1 * c4;
                            u32x2 w1, w2; w1.x = cvt_pk_bf16(o1[0], o1[1]); w1.y = cvt_pk_bf16(o1[2], o1[3]); w2.x = cvt_pk_bf16(o2[0], o2[1]); w2.y = cvt_pk_bf16(o2[2], o2[3]);
                            *(u32x2*)dst = w1; *(u32x2*)(dst + 64) = w2; } }
            } else {
                const int p0 = 32 * wc + 8 * fq;
#pragma unroll
                for (int ai = 0; ai < 2; ++ai)
#pragma unroll
                    for (int m = 0; m < 4; ++m) { const int row = row0 + ai * HALF + m * 16, b = row >> 12, s = row & 4095;
                        const int rih = ((s & ((1 << dsh) - 1)) << (12 - dsh)) + (s >> dsh);
#pragma unroll
                        for (int bj = 0; bj < 2; ++bj) { bf16_t* dst = base + ((size_t)(b * nh + j0 + bj) * 4096 + rih) * 128 + p0;
                            *(u32x4*)dst = pack8(acc[ai][bj][m][0] * zs, acc[ai][bj][m][1] * zs); } }
            }
        }
    }
};
struct EpiBranchA {
    static constexpr bool PERM = true, AFTER_DRAIN = false;
    bf16_t* G; float zs;
    __device__ __forceinline__ void operator()(const f32x4 (&acc)[2][2][4][2], const Unit& u, int wr, int wc, int fr, int fq) const {
        const int row0 = u.pm * BM + wr * 64 + fr, col0 = u.pn * BM + wc * 32 + 8 * fq;
#pragma unroll
        for (int ai = 0; ai < 2; ++ai)
#pragma unroll
            for (int m = 0; m < 4; ++m) { bf16_t* rowp = G + (size_t)(row0 + ai * HALF + m * 16) * 4096 + col0;
#pragma unroll
                for (int bj = 0; bj < 2; ++bj) { f32x4 g0, g1; unpack8(*(const u32x4*)(rowp + bj * HALF), g0, g1);
                    *(u32x4*)(rowp + bj * HALF) = pack8(g0 * (acc[ai][bj][m][0] * zs), g1 * (acc[ai][bj][m][1] * zs)); } }
    }
};
struct EpiBranchB {
    static constexpr bool PERM = true, AFTER_DRAIN = false;
    const bf16_t* G; unsigned char* O; float zs;
    __device__ __forceinline__ void operator()(const f32x4 (&acc)[2][2][4][2], const Unit& u, int wr, int wc, int fr, int fq) const {
        const int row0 = u.pm * BM + wr * 64 + fr, col0 = u.pn * BM + wc * 32 + 8 * fq;
#pragma unroll
        for (int ai = 0; ai < 2; ++ai)
#pragma unroll
            for (int m = 0; m < 4; ++m) { const size_t row = (size_t)(row0 + ai * HALF + m * 16); const bf16_t* gp = G + row * 4096 + col0; unsigned char* op = O + row * 2048 + col0;
#pragma unroll
                for (int bj = 0; bj < 2; ++bj) { f32x4 t0, t1, g0, g1; unpack8(*(const u32x4*)(gp + bj * HALF), t0, t1); unpack8(*(const u32x4*)(gp + 2048 + bj * HALF), g0, g1);
                    const f32x4 m0 = (t0 + g0 * (acc[ai][bj][m][0] * zs)) * 32.0f, m1 = (t1 + g1 * (acc[ai][bj][m][1] * zs)) * 32.0f;
                    int w0 = 0, w1 = 0; w0 = CVT2_FP8(m0[0], m0[1], w0, false); w0 = CVT2_FP8(m0[2], m0[3], w0, true);
                    w1 = CVT2_FP8(m1[0], m1[1], w1, false); w1 = CVT2_FP8(m1[2], m1[3], w1, true);
                    *(u32x2*)(op + bj * HALF) = (u32x2){(unsigned)w0, (unsigned)w1}; } }
    }
};
struct EpiWout {
    static constexpr bool PERM = true, AFTER_DRAIN = false;
    const float* X; bf16_t* Y; float alpha, zs;
    __device__ __forceinline__ void operator()(const f32x4 (&acc)[2][2][4][2], const Unit& u, int wr, int wc, int fr, int fq) const {
        const int row0 = u.pm * BM + wr * 64 + fr, col0 = u.pn * BM + wc * 32 + 8 * fq;
#pragma unroll
        for (int ai = 0; ai < 2; ++ai)
#pragma unroll
            for (int m = 0; m < 4; ++m) { const size_t off = (size_t)(row0 + ai * HALF + m * 16) * 2048 + col0;
#pragma unroll
                for (int bj = 0; bj < 2; ++bj) { const f32x4 x0 = *(const f32x4*)(X + off + bj * HALF), x1 = *(const f32x4*)(X + off + bj * HALF + 4);
                    *(u32x4*)(Y + off + bj * HALF) = pack8(x0 * alpha + acc[ai][bj][m][0] * zs, x1 * alpha + acc[ai][bj][m][1] * zs); } }
    }
};
struct EpiPlain {
    static constexpr bool PERM = true, AFTER_DRAIN = false;
    bf16_t* O; int ldc;
    __device__ __forceinline__ void operator()(const f32x4 (&acc)[2][2][4][2], const Unit& u, int wr, int wc, int fr, int fq) const {
        const int row0 = u.pm * BM + wr * 64 + fr, col0 = u.pn * BM + wc * 32 + 8 * fq;
#pragma unroll
        for (int ai = 0; ai < 2; ++ai)
#pragma unroll
            for (int m = 0; m < 4; ++m) { bf16_t* rowp = O + (size_t)(row0 + ai * HALF + m * 16) * ldc + col0;
#pragma unroll
                for (int bj = 0; bj < 2; ++bj) *(u32x4*)(rowp + bj * HALF) = pack8(acc[ai][bj][m][0], acc[ai][bj][m][1]); }
    }
};
struct EpiQG {
    static constexpr bool PERM = true, AFTER_DRAIN = false;
    bf16_t* Q; bf16_t* PP;
    __device__ __forceinline__ void operator()(const f32x4 (&acc)[2][2][4][2], const Unit& u, int wr, int wc, int fr, int fq) const {
        const int row0 = u.pm * BM + wr * 64 + fr; const bool isq = u.pn < 8; const int col0 = (u.pn & 7) * BM + wc * 32 + 8 * fq;
        bf16_t* base = isq ? Q : PP;
#pragma unroll
        for (int ai = 0; ai < 2; ++ai)
#pragma unroll
            for (int m = 0; m < 4; ++m) { bf16_t* rowp = base + (size_t)(row0 + ai * HALF + m * 16) * 2048 + col0;
#pragma unroll
                for (int bj = 0; bj < 2; ++bj) { f32x4 v0 = acc[ai][bj][m][0], v1 = acc[ai][bj][m][1];
                    if (!isq) { f32x4 p0, p1; unpack8(*(const u32x4*)(rowp + bj * HALF), p0, p1);
#pragma unroll
                        for (int i = 0; i < 4; ++i) { v0[i] = sigmoidf_(v0[i]) * p0[i]; v1[i] = sigmoidf_(v1[i]) * p1[i]; } }
                    *(u32x4*)(rowp + bj * HALF) = pack8(v0, v1); } }
    }
};
struct EpiPle {
    static constexpr bool PERM = true, AFTER_DRAIN = false;
    bf16_t* PP; float zs;
    __device__ __forceinline__ void operator()(const f32x4 (&acc)[2][2][4][2], const Unit& u, int wr, int wc, int fr, int fq) const {
        const int row0 = u.pm * BM + wr * 64 + fr, col0 = u.pn * BM + wc * 32 + 8 * fq;
#pragma unroll
        for (int ai = 0; ai < 2; ++ai)
#pragma unroll
            for (int m = 0; m < 4; ++m) { bf16_t* rowp = PP + (size_t)(row0 + ai * HALF + m * 16) * 2048 + col0;
#pragma unroll
                for (int bj = 0; bj < 2; ++bj) { f32x4 v0 = acc[ai][bj][m][0] * zs, v1 = acc[ai][bj][m][1] * zs; f32x4 p0, p1; unpack8(*(const u32x4*)(rowp + bj * HALF), p0, p1);
#pragma unroll
                    for (int i = 0; i < 4; ++i) { v0[i] = sigmoidf_(v0[i]) * p0[i]; v1[i] = sigmoidf_(v1[i]) * p1[i]; }
                    *(u32x4*)(rowp + bj * HALF) = pack8(v0, v1); } }
    }
};
template <class Epi, class Sched, bool ALIGN_EPI = false, bool SP2 = false>
__device__ __forceinline__ void gemm_phase(PG8_LAS unsigned char* lds, const Gemm g, const Sched& S, const Epi& E) {
    const int tid = threadIdx.x, wid = __builtin_amdgcn_readfirstlane(tid >> 6), lane = tid & 63, wr = wid >> 2, wc = wid & 3, fr = lane & 15, fq = lane >> 4;
    const int K = g.K, nt = K / BK;
    unsigned voffA[2], voffB[2];
#pragma unroll
    for (int i = 0; i < 2; ++i) { int R, C; stage_rc(tid * 16 + i * 8192, R, C); const int Rb = Epi::PERM ? ((R & ~31) + perm32(R & 31)) : R;
        voffA[i] = (unsigned)(R * K + C) * 2u; voffB[i] = (unsigned)(Rb * K + C) * 2u; }
    const size_t kstep = (size_t)(BK * 2);
    const size_t hstep = (size_t)HALF * K * 2;
    const size_t tstep = 2 * hstep;
    const unsigned ldsw = (unsigned)wid * 1024u;
    const int aoff = lds_byte(wr * 64 + fr, fq * 8), boff = lds_byte(wc * 32 + fr, fq * 8);
#define PG8_SA(b, h) (((b) * 2 + (h)) * HTB)
#define PG8_SB(b, h) ((4 + (b) * 2 + (h)) * HTB)
#define PG8_STAGE(bufoff, gbase, voff) do { _Pragma("unroll") for (int _i = 0; _i < 2; ++_i) \
        __builtin_amdgcn_global_load_lds((const unsigned*)((const char*)(gbase) + (voff)[_i]), (PG8_LAS unsigned*)(lds + (bufoff) + ldsw + _i * 8192), 16, 0, 0); } while (0)
#define PG8_LDA(dst, b, h) do { _Pragma("unroll") for (int m = 0; m < 4; ++m) _Pragma("unroll") for (int k = 0; k < 2; ++k) dst[m][k] = *(const PG8_LAS bf16x8*)(lds + PG8_SA(b, h) + aoff + m * 2048 + k * 1024); } while (0)
#define PG8_LDB(dst, b, h) do { _Pragma("unroll") for (int n = 0; n < 2; ++n) _Pragma("unroll") for (int k = 0; k < 2; ++k) dst[n][k] = *(const PG8_LAS bf16x8*)(lds + PG8_SB(b, h) + boff + n * 2048 + k * 1024); } while (0)
#define PG8_MMA(ai, bj, At, Bt) do { __builtin_amdgcn_s_setprio(1); _Pragma("unroll") for (int m = 0; m < 4; ++m) _Pragma("unroll") for (int n = 0; n < 2; ++n) _Pragma("unroll") for (int k = 0; k < 2; ++k) \
        acc[ai][bj][m][n] = __builtin_amdgcn_mfma_f32_16x16x32_bf16(Bt[n][k], At[m][k], acc[ai][bj][m][n], 0, 0, 0); __builtin_amdgcn_s_setprio(0); } while (0)
#define PG8_WAIT_V(n) asm volatile("s_waitcnt vmcnt(" #n ")" ::: "memory")
#define PG8_WAIT_L(n) asm volatile("s_waitcnt lgkmcnt(" #n ")" ::: "memory")
#define PG8_BAR __builtin_amdgcn_s_barrier()
#define PG8_SCHED __builtin_amdgcn_sched_barrier(0)
    Unit cur, nxt; int ui = 0;
    if (!S.next(0, cur)) return;
    f32x4 acc[2][2][4][2];
#pragma unroll
    for (int a = 0; a < 2; ++a)
#pragma unroll
        for (int b = 0; b < 2; ++b)
#pragma unroll
            for (int m = 0; m < 4; ++m)
#pragma unroll
                for (int n = 0; n < 2; ++n) acc[a][b][m][n] = (f32x4){0.f, 0.f, 0.f, 0.f};
    bf16x8 At[4][2], B0[2][2], B1[2][2];
    const char* cA = (const char*)g.A + (size_t)cur.pm * tstep; const char* cB = (const char*)g.Bt + (size_t)cur.pn * tstep;
    S.a_ready(cur);
    if constexpr (SP2) {
        PG8_STAGE(PG8_SB(0, 0), cB, voffB); PG8_STAGE(PG8_SB(0, 1), cB + hstep, voffB); PG8_STAGE(PG8_SA(0, 0), cA, voffA); PG8_STAGE(PG8_SA(0, 1), cA + hstep, voffA);
        if (wr == 1) PG8_BAR;
        PG8_WAIT_V(2); PG8_BAR;
        PG8_STAGE(PG8_SB(1, 0), cB + kstep, voffB); PG8_STAGE(PG8_SA(1, 0), cA + kstep, voffA); PG8_STAGE(PG8_SB(1, 1), cB + hstep + kstep, voffB);
        PG8_WAIT_V(6); PG8_BAR;
    } else {
        PG8_STAGE(PG8_SB(0, 0), cB, voffB); PG8_STAGE(PG8_SA(0, 0), cA, voffA); PG8_STAGE(PG8_SB(0, 1), cB + hstep, voffB); PG8_STAGE(PG8_SA(0, 1), cA + hstep, voffA);
        if (wr == 1) PG8_BAR;
        PG8_WAIT_V(4); PG8_BAR;
        PG8_STAGE(PG8_SB(1, 0), cB + kstep, voffB); PG8_STAGE(PG8_SA(1, 0), cA + kstep, voffA); PG8_STAGE(PG8_SB(1, 1), cB + hstep + kstep, voffB);
        PG8_WAIT_V(6); PG8_BAR;
    }
    for (;;) {
        const bool has_next = S.next(ui + 1, nxt);
        const char* nA = has_next ? (const char*)g.A + (size_t)nxt.pm * tstep : cA; const char* nB = has_next ? (const char*)g.Bt + (size_t)nxt.pn * tstep : cB;
        for (int t = 0; t < nt; t += 2) {
            const bool last = (t == nt - 2);
            const char* a1 = cA + (size_t)(t + 1) * kstep;
            const char* a2 = last ? nA : cA + (size_t)(t + 2) * kstep; const char* b2 = last ? nB : cB + (size_t)(t + 2) * kstep;
            const char* a3 = a2 + kstep; const char* b3 = b2 + kstep;
            if (last && has_next) S.a_ready(nxt);
            if constexpr (SP2) {
            PG8_LDB(B0, 0, 0); PG8_LDB(B1, 0, 1); PG8_SCHED; PG8_LDA(At, 0, 0); PG8_STAGE(PG8_SA(1, 1), a1 + hstep, voffA);
            PG8_WAIT_V(8); PG8_WAIT_L(0); PG8_BAR; PG8_MMA(0, 0, At, B0); PG8_MMA(0, 1, At, B1); PG8_BAR; PG8_SCHED;
            PG8_LDA(At, 0, 1); PG8_STAGE(PG8_SB(0, 0), b2, voffB); PG8_STAGE(PG8_SB(0, 1), b2 + hstep, voffB); PG8_STAGE(PG8_SA(0, 0), a2, voffA);
            PG8_WAIT_V(8); PG8_WAIT_L(0); PG8_BAR; PG8_MMA(1, 0, At, B0); PG8_MMA(1, 1, At, B1); PG8_BAR; PG8_SCHED;
            PG8_LDB(B0, 1, 0); PG8_LDB(B1, 1, 1); PG8_SCHED; PG8_LDA(At, 1, 0); PG8_STAGE(PG8_SA(0, 1), a2 + hstep, voffA);
            PG8_WAIT_V(8); PG8_WAIT_L(0); PG8_BAR; PG8_MMA(0, 0, At, B0); PG8_MMA(0, 1, At, B1); PG8_BAR; PG8_SCHED;
            PG8_LDA(At, 1, 1); PG8_STAGE(PG8_SB(1, 0), b3, voffB); PG8_STAGE(PG8_SB(1, 1), b3 + hstep, voffB); PG8_STAGE(PG8_SA(1, 0), a3, voffA);
            PG8_WAIT_V(8); PG8_WAIT_L(0); PG8_BAR; PG8_MMA(1, 0, At, B0); PG8_MMA(1, 1, At, B1); PG8_BAR; PG8_SCHED;
            } else {
            PG8_LDB(B0, 0, 0); PG8_SCHED; PG8_LDA(At, 0, 0); PG8_STAGE(PG8_SA(1, 1), a1 + hstep, voffA);
            PG8_WAIT_L(8); PG8_BAR; PG8_WAIT_L(0); PG8_MMA(0, 0, At, B0); PG8_BAR; PG8_SCHED;
            PG8_LDB(B1, 0, 1); PG8_STAGE(PG8_SB(0, 0), b2, voffB);
            PG8_BAR; PG8_WAIT_L(0); PG8_MMA(0, 1, At, B1); PG8_BAR;
            PG8_LDA(At, 0, 1); PG8_STAGE(PG8_SA(0, 0), a2, voffA);
            PG8_BAR; PG8_WAIT_L(0); PG8_MMA(1, 0, At, B0); PG8_BAR; PG8_SCHED;
            PG8_STAGE(PG8_SB(0, 1), b2 + hstep, voffB);
            PG8_WAIT_V(6); PG8_BAR; PG8_MMA(1, 1, At, B1); PG8_BAR;
            PG8_LDB(B0, 1, 0); PG8_SCHED; PG8_LDA(At, 1, 0); PG8_STAGE(PG8_SA(0, 1), a2 + hstep, voffA);
            PG8_WAIT_L(8); PG8_BAR; PG8_WAIT_L(0); PG8_MMA(0, 0, At, B0); PG8_BAR; PG8_SCHED;
            PG8_LDB(B1, 1, 1); PG8_STAGE(PG8_SB(1, 0), b3, voffB);
            PG8_BAR; PG8_WAIT_L(0); PG8_MMA(0, 1, At, B1); PG8_BAR;
            PG8_LDA(At, 1, 1); PG8_STAGE(PG8_SA(1, 0), a3, voffA);
            PG8_BAR; PG8_WAIT_L(0); PG8_MMA(1, 0, At, B0); PG8_BAR; PG8_SCHED;
            PG8_STAGE(PG8_SB(1, 1), b3 + hstep, voffB);
            PG8_WAIT_V(6); PG8_BAR; PG8_MMA(1, 1, At, B1); PG8_BAR;
            }
        }
        if constexpr (ALIGN_EPI) { if (wr == 0) PG8_BAR; }
        if constexpr (!Epi::AFTER_DRAIN) { E(acc, cur, wr, wc, fr, fq); S.done(cur); }
        if (!has_next) break;
#pragma unroll
        for (int a = 0; a < 2; ++a)
#pragma unroll
            for (int b = 0; b < 2; ++b)
#pragma unroll
                for (int m = 0; m < 4; ++m)
#pragma unroll
                    for (int n = 0; n < 2; ++n) acc[a][b][m][n] = (f32x4){0.f, 0.f, 0.f, 0.f};
        cur = nxt; cA = nA; cB = nB; ++ui;
        if constexpr (ALIGN_EPI) { if (wr == 1) PG8_BAR; }
    }
    PG8_WAIT_V(0);
    if constexpr (!ALIGN_EPI) { if (wr == 0) PG8_BAR; }
    PG8_BAR;
    if constexpr (Epi::AFTER_DRAIN) { E.fused(acc, cur, wr, wc, fr, fq, lds, wid, lane); S.done(cur); }
#undef PG8_SA
#undef PG8_SB
#undef PG8_STAGE
#undef PG8_LDA
#undef PG8_LDB
#undef PG8_MMA
#undef PG8_WAIT_V
#undef PG8_WAIT_L
#undef PG8_BAR
#undef PG8_SCHED
}
typedef int i32x8 __attribute__((ext_vector_type(8)));
template <class Epi, class Sched, bool ALIGN_EPI = false, bool SP2 = false>
__device__ __forceinline__ void gemm_phase8(PG8_LAS unsigned char* lds, const Gemm g, const Sched& S, const Epi& E) {
    const int tid = threadIdx.x, wid = __builtin_amdgcn_readfirstlane(tid >> 6), lane = tid & 63, wr = wid >> 2, wc = wid & 3, fr = lane & 15, fq = lane >> 4;
    const int K = g.K  , nt = K / 128;
    unsigned sc1 = 0x7f7f7f7fu; asm volatile("" : "+v"(sc1));
    unsigned voffA[2], voffB[2];
#pragma unroll
    for (int i = 0; i < 2; ++i) { int R, C; stage_rc(tid * 16 + i * 8192, R, C); const int Rb = Epi::PERM ? ((R & ~31) + perm32(R & 31)) : R;
        voffA[i] = (unsigned)(R * K + 2 * C); voffB[i] = (unsigned)(Rb * K + 2 * C); }
    const size_t kstep = (size_t)(BK * 2);
    const size_t hstep = (size_t)HALF * K;
    const size_t tstep = 2 * hstep;
    const unsigned ldsw = (unsigned)wid * 1024u;
    const int aoff = lds_byte(wr * 64 + fr, (fq & 1) * 16) + (fq >> 1) * 1024, boff = lds_byte(wc * 32 + fr, (fq & 1) * 16) + (fq >> 1) * 1024;
#define PG8_SA(b, h) (((b) * 2 + (h)) * HTB)
#define PG8_SB(b, h) ((4 + (b) * 2 + (h)) * HTB)
#define PG8_STAGE(bufoff, gbase, voff) do { _Pragma("unroll") for (int _i = 0; _i < 2; ++_i) \
        __builtin_amdgcn_global_load_lds((const unsigned*)((const char*)(gbase) + (voff)[_i]), (PG8_LAS unsigned*)(lds + (bufoff) + ldsw + _i * 8192), 16, 0, 0); } while (0)
#define PG8_LDA(dst, b, h) do { _Pragma("unroll") for (int m = 0; m < 4; ++m) dst[m] = *(const PG8_LAS i32x8*)(lds + PG8_SA(b, h) + aoff + m * 2048); } while (0)
#define PG8_LDB(dst, b, h) do { _Pragma("unroll") for (int n = 0; n < 2; ++n) dst[n] = *(const PG8_LAS i32x8*)(lds + PG8_SB(b, h) + boff + n * 2048); } while (0)
#define PG8_MMA(ai, bj, At, Bt) do { __builtin_amdgcn_s_setprio(1); _Pragma("unroll") for (int m = 0; m < 4; ++m) _Pragma("unroll") for (int n = 0; n < 2; ++n) \
        asm volatile("v_mfma_scale_f32_16x16x128_f8f6f4 %0, %1, %2, %0, %3, %3 op_sel_hi:[0,0,0]" : "+v"(acc[ai][bj][m][n]) : "v"(Bt[n]), "v"(At[m]), "v"(sc1)); __builtin_amdgcn_s_setprio(0); } while (0)
#define PG8_WAIT_V(n) asm volatile("s_waitcnt vmcnt(" #n ")" ::: "memory")
#define PG8_WAIT_L(n) asm volatile("s_waitcnt lgkmcnt(" #n ")" ::: "memory")
#define PG8_BAR __builtin_amdgcn_s_barrier()
#define PG8_SCHED __builtin_amdgcn_sched_barrier(0)
    Unit cur, nxt; int ui = 0;
    if (!S.next(0, cur)) return;
    f32x4 acc[2][2][4][2];
#pragma unroll
    for (int a = 0; a < 2; ++a)
#pragma unroll
        for (int b = 0; b < 2; ++b)
#pragma unroll
            for (int m = 0; m < 4; ++m)
#pragma unroll
                for (int n = 0; n < 2; ++n) acc[a][b][m][n] = (f32x4){0.f, 0.f, 0.f, 0.f};
    i32x8 At[4], B0[2], B1[2];
    const char* cA = (const char*)g.A + (size_t)cur.pm * tstep; const char* cB = (const char*)g.Bt + (size_t)cur.pn * tstep;
    S.a_ready(cur);
    if constexpr (SP2) {
        PG8_STAGE(PG8_SB(0, 0), cB, voffB); PG8_STAGE(PG8_SB(0, 1), cB + hstep, voffB); PG8_STAGE(PG8_SA(0, 0), cA, voffA); PG8_STAGE(PG8_SA(0, 1), cA + hstep, voffA);
        if (wr == 1) PG8_BAR;
        PG8_WAIT_V(2); PG8_BAR;
        PG8_STAGE(PG8_SB(1, 0), cB + kstep, voffB); PG8_STAGE(PG8_SA(1, 0), cA + kstep, voffA); PG8_STAGE(PG8_SB(1, 1), cB + hstep + kstep, voffB);
        PG8_WAIT_V(6); PG8_BAR;
    } else {
        PG8_STAGE(PG8_SB(0, 0), cB, voffB); PG8_STAGE(PG8_SA(0, 0), cA, voffA); PG8_STAGE(PG8_SB(0, 1), cB + hstep, voffB); PG8_STAGE(PG8_SA(0, 1), cA + hstep, voffA);
        if (wr == 1) PG8_BAR;
        PG8_WAIT_V(4); PG8_BAR;
        PG8_STAGE(PG8_SB(1, 0), cB + kstep, voffB); PG8_STAGE(PG8_SA(1, 0), cA + kstep, voffA); PG8_STAGE(PG8_SB(1, 1), cB + hstep + kstep, voffB);
        PG8_WAIT_V(6); PG8_BAR;
    }
    for (;;) {
        const bool has_next = S.next(ui + 1, nxt);
        const char* nA = has_next ? (const char*)g.A + (size_t)nxt.pm * tstep : cA; const char* nB = has_next ? (const char*)g.Bt + (size_t)nxt.pn * tstep : cB;
        for (int t = 0; t < nt; t += 2) {
            const bool last = (t == nt - 2);
            const char* a1 = cA + (size_t)(t + 1) * kstep;
            const char* a2 = last ? nA : cA + (size_t)(t + 2) * kstep; const char* b2 = last ? nB : cB + (size_t)(t + 2) * kstep;
            const char* a3 = a2 + kstep; const char* b3 = b2 + kstep;
            if (last && has_next) S.a_ready(nxt);
            if constexpr (SP2) {
            PG8_LDB(B0, 0, 0); PG8_LDB(B1, 0, 1); PG8_SCHED; PG8_LDA(At, 0, 0); PG8_STAGE(PG8_SA(1, 1), a1 + hstep, voffA);
            PG8_WAIT_V(8); PG8_WAIT_L(0); PG8_BAR; PG8_MMA(0, 0, At, B0); PG8_MMA(0, 1, At, B1); PG8_BAR; PG8_SCHED;
            PG8_LDA(At, 0, 1); PG8_STAGE(PG8_SB(0, 0), b2, voffB); PG8_STAGE(PG8_SB(0, 1), b2 + hstep, voffB); PG8_STAGE(PG8_SA(0, 0), a2, voffA);
            PG8_WAIT_V(8); PG8_WAIT_L(0); PG8_BAR; PG8_MMA(1, 0, At, B0); PG8_MMA(1, 1, At, B1); PG8_BAR; PG8_SCHED;
            PG8_LDB(B0, 1, 0); PG8_LDB(B1, 1, 1); PG8_SCHED; PG8_LDA(At, 1, 0); PG8_STAGE(PG8_SA(0, 1), a2 + hstep, voffA);
            PG8_WAIT_V(8); PG8_WAIT_L(0); PG8_BAR; PG8_MMA(0, 0, At, B0); PG8_MMA(0, 1, At, B1); PG8_BAR; PG8_SCHED;
            PG8_LDA(At, 1, 1); PG8_STAGE(PG8_SB(1, 0), b3, voffB); PG8_STAGE(PG8_SB(1, 1), b3 + hstep, voffB); PG8_STAGE(PG8_SA(1, 0), a3, voffA);
            PG8_WAIT_V(8); PG8_WAIT_L(0); PG8_BAR; PG8_MMA(1, 0, At, B0); PG8_MMA(1, 1, At, B1); PG8_BAR; PG8_SCHED;
            } else {
            PG8_LDB(B0, 0, 0); PG8_SCHED; PG8_LDA(At, 0, 0); PG8_STAGE(PG8_SA(1, 1), a1 + hstep, voffA);
            PG8_WAIT_L(8); PG8_BAR; PG8_WAIT_L(0); PG8_MMA(0, 0, At, B0); PG8_BAR; PG8_SCHED;
            PG8_LDB(B1, 0, 1); PG8_STAGE(PG8_SB(0, 0), b2, voffB);
            PG8_BAR; PG8_WAIT_L(0); PG8_MMA(0, 1, At, B1); PG8_BAR;
            PG8_LDA(At, 0, 1); PG8_STAGE(PG8_SA(0, 0), a2, voffA);
            PG8_BAR; PG8_WAIT_L(0); PG8_MMA(1, 0, At, B0); PG8_BAR; PG8_SCHED;
            PG8_STAGE(PG8_SB(0, 1), b2 + hstep, voffB);
            PG8_WAIT_V(6); PG8_BAR; PG8_MMA(1, 1, At, B1); PG8_BAR;
            PG8_LDB(B0, 1, 0); PG8_SCHED; PG8_LDA(At, 1, 0); PG8_STAGE(PG8_SA(0, 1), a2 + hstep, voffA);
            PG8_WAIT_L(8); PG8_BAR; PG8_WAIT_L(0); PG8_MMA(0, 0, At, B0); PG8_BAR; PG8_SCHED;
            PG8_LDB(B1, 1, 1); PG8_STAGE(PG8_SB(1, 0), b3, voffB);
            PG8_BAR; PG8_WAIT_L(0); PG8_MMA(0, 1, At, B1); PG8_BAR;
            PG8_LDA(At, 1, 1); PG8_STAGE(PG8_SA(1, 0), a3, voffA);
            PG8_BAR; PG8_WAIT_L(0); PG8_MMA(1, 0, At, B0); PG8_BAR; PG8_SCHED;
            PG8_STAGE(PG8_SB(1, 1), b3 + hstep, voffB);
            PG8_WAIT_V(6); PG8_BAR; PG8_MMA(1, 1, At, B1); PG8_BAR;
            }
        }
        asm volatile("s_nop 15\n\ts_nop 15" ::: "memory");
        if constexpr (ALIGN_EPI) { if (wr == 0) PG8_BAR; }
        if constexpr (!Epi::AFTER_DRAIN) { E(acc, cur, wr, wc, fr, fq); S.done(cur); }
        if (!has_next) break;
#pragma unroll
        for (int a = 0; a < 2; ++a)
#pragma unroll
            for (int b = 0; b < 2; ++b)
#pragma unroll
                for (int m = 0; m < 4; ++m)
#pragma unroll
                    for (int n = 0; n < 2; ++n) acc[a][b][m][n] = (f32x4){0.f, 0.f, 0.f, 0.f};
        cur = nxt; cA = nA; cB = nB; ++ui;
        if constexpr (ALIGN_EPI) { if (wr == 1) PG8_BAR; }
    }
    PG8_WAIT_V(0);
    if constexpr (!ALIGN_EPI) { if (wr == 0) PG8_BAR; }
    PG8_BAR;
    if constexpr (Epi::AFTER_DRAIN) { E.fused(acc, cur, wr, wc, fr, fq, lds, wid, lane); S.done(cur); }
#undef PG8_SA
#undef PG8_SB
#undef PG8_STAGE
#undef PG8_LDA
#undef PG8_LDB
#undef PG8_MMA
#undef PG8_WAIT_V
#undef PG8_WAIT_L
#undef PG8_BAR
#undef PG8_SCHED
}
}
constexpr int NWAVES = 8;
constexpr int NB = 4, S = 4096, D = 2048, T = NB * S;
constexpr int IN_COLS = 10240, NQG = 4096;
constexpr int NPHASES = 11;
#ifndef WGM_P1
#define WGM_P1 2
#endif
#ifndef WGM_X
#define WGM_X 2
#endif
#ifndef PEER_U_FP4
#define PEER_U_FP4 0
#endif
#define PEER_U_SCALE (PEER_U_FP4 ? 54.0f : 64.0f)
#ifndef MK_N_LAUNCHES
#define MK_N_LAUNCHES 1
#endif
constexpr int N_LAUNCHES = MK_N_LAUNCHES;
constexpr float LN_EPS = 1e-5f;
constexpr float DN_ALPHA = 1.189207115002721f;
constexpr size_t MiB = 1u << 20;
constexpr size_t WS_CTL = 0, CTL_ZERO_BYTES = 1 * MiB;
constexpr size_t WS_COS = 1 * MiB, WS_SIN = 2 * MiB;
constexpr size_t WS_WBA = 3 * MiB;
constexpr size_t WS_WBB = 5 * MiB;
constexpr size_t WS_WOUT = 9 * MiB;
constexpr size_t WS_WQG = 17 * MiB;
constexpr size_t WS_WPP = 33 * MiB;
constexpr size_t WS_SK = 34 * MiB;
constexpr size_t WS_PB = 35 * MiB;
constexpr size_t WS_QA = 43 * MiB, WS_KA = 91 * MiB, WS_VA = 139 * MiB;
constexpr size_t WS_QB = 187 * MiB, WS_KB = 219 * MiB, WS_VB = 227 * MiB;
constexpr size_t WS_UB = 43 * MiB, WS_VT = 67 * MiB;
constexpr size_t WS_MERGED = 171 * MiB;
constexpr size_t WS_Q = 171 * MiB;
constexpr size_t WS_G = 235 * MiB;
constexpr size_t WS_H1 = 235 * MiB;
constexpr size_t WS_WIN = 363 * MiB;
constexpr size_t WS_XB = 403 * MiB;
constexpr size_t WS_OG = 363 * MiB;
constexpr size_t WS_ML = 411 * MiB;
constexpr size_t WS_OB = 413 * MiB;
constexpr size_t WS_OA = 445 * MiB;
constexpr size_t WS_H1F8 = 299 * MiB;
constexpr size_t WS_H1B = 363 * MiB;
constexpr size_t WS_PP = 427 * MiB;
constexpr size_t WS_IDX = 491 * MiB, WS_GATE = 499 * MiB;
constexpr size_t WS_END = 507 * MiB;
constexpr int CW_BAR = 4096;
constexpr int RING_OFF = 0, RING_BYTES = 131072;
constexpr int LDSCTL_OFF = RING_BYTES, MISC_OFF = LDSCTL_OFF + 320;
constexpr int LDS_BYTES = 163840;
constexpr int ACTW_OFF = LDSCTL_OFF + 1024;
#define GAS __attribute__((address_space(1)))
#define LAS __attribute__((address_space(3)))
typedef unsigned short bf16;
typedef unsigned v4u __attribute__((ext_vector_type(4)));
typedef float f32x4 __attribute__((ext_vector_type(4)));
typedef short bf16x8 __attribute__((ext_vector_type(8)));
typedef GAS unsigned gu32;
typedef GAS unsigned long long gu64;
#define RLX_AGENT __ATOMIC_RELAXED, __HIP_MEMORY_SCOPE_AGENT
#define LDS_WAIT() asm volatile("s_waitcnt lgkmcnt(0)" ::: "memory")
#define VM_WAIT() asm volatile("s_waitcnt vmcnt(0)" ::: "memory")
__device__ __forceinline__ unsigned long long rt() { return __builtin_amdgcn_s_memrealtime(); }
__device__ __forceinline__ unsigned f2bf(float f) { unsigned u = __builtin_bit_cast(unsigned, f); return (u + 0x7fffu + ((u >> 16) & 1u)) >> 16; }
__device__ __forceinline__ unsigned pk2(float lo, float hi) { return f2bf(lo) | (f2bf(hi) << 16); }

#define XB_TMO      128
#define XB_XCNT(j)  (256  + 64 * (j))
#define XB_XSUB(j)  (1280 + 64 * (j))
#define XB_XGEN(j)  (2304 + 64 * (j))
#define XB_TOP      3328
#define XB_TOPGEN   3392
#define XCD_BAR_WORDS 3456
#define XB_SPIN_CAP (1u << 18)

__device__ __forceinline__ unsigned xb_ld(unsigned* p)              { return __hip_atomic_load(p, __ATOMIC_RELAXED, __HIP_MEMORY_SCOPE_AGENT); }
__device__ __forceinline__ unsigned xb_add(unsigned* p, unsigned v) { return __hip_atomic_fetch_add(p, v, __ATOMIC_RELAXED, __HIP_MEMORY_SCOPE_AGENT); }
__device__ __forceinline__ unsigned xb_xcc_id() { return (unsigned)__builtin_amdgcn_s_getreg((3 << 11) | 20) & 0xFu; }
#define XB_SPIN(cond, bar) do { unsigned _sp = 0; while (cond) { __builtin_amdgcn_s_sleep(1); \
    if ((++_sp & 255u) == 0u) { if (xb_ld(&(bar)[XB_TMO])) break; if (_sp > XB_SPIN_CAP) { atomicAdd(&(bar)[XB_TMO], 1u); break; } } } } while (0)

struct XcdBarrier {
    unsigned* bar; unsigned x;
    volatile LAS unsigned* st;
};

__device__ __forceinline__ XcdBarrier xcd_barrier_post(unsigned* bar, volatile LAS unsigned* st) {
    XcdBarrier b; b.bar = bar; b.x = xb_xcc_id(); b.st = st;
    if (threadIdx.x == 0) (void)xb_add(&bar[XB_XCNT(b.x)], 1u);
    return b;
}
__device__ __forceinline__ void xcd_barrier_complete(unsigned* bar, unsigned x, unsigned& nloc, unsigned& nx) {
    const unsigned G = gridDim.x * gridDim.y * gridDim.z;
    unsigned sum, cnt, mine, sp = 0u;
    for (;;) {
        sum = 0u; cnt = 0u; mine = 0u;
#pragma unroll
        for (unsigned j = 0; j < 16; ++j) { const unsigned c = xb_ld(&bar[XB_XCNT(j)]); sum += c; cnt += (c > 0u) ? 1u : 0u; mine = (j == x) ? c : mine; }
        if (sum == G) break;
        __builtin_amdgcn_s_sleep(1);
        if ((++sp & 255u) == 0u) { if (xb_ld(&bar[XB_TMO])) break; if (sp > XB_SPIN_CAP) { atomicAdd(&bar[XB_TMO], 1u); break; } }
    }
    nloc = mine > 0u ? mine : 1u; nx = cnt > 0u ? cnt : 1u;
}

__device__ __forceinline__ void xcd_barrier(const XcdBarrier& b) {
    asm volatile("s_waitcnt vmcnt(0)" ::: "memory");
    __syncthreads();
    if (threadIdx.x == 0) {
        unsigned* bar = b.bar;
        __builtin_amdgcn_s_waitcnt(0);
        unsigned nloc = b.st[0], nx = b.st[1];
        if (nloc == 0u) { xcd_barrier_complete(bar, b.x, nloc, nx); b.st[0] = nloc; b.st[1] = nx; }
        const unsigned old = xb_add(&bar[XB_XSUB(b.x)], 1u);
        const unsigned gen = old / nloc;
        if (old + 1u == (gen + 1u) * nloc) {
            __builtin_amdgcn_fence(__ATOMIC_RELEASE, "agent");
            asm volatile("s_waitcnt vmcnt(0)" ::: "memory");
            const unsigned og = xb_add(&bar[XB_TOP], 1u);
            const unsigned tg = og / nx;
            if (og + 1u == (tg + 1u) * nx) xb_add(&bar[XB_TOPGEN], 1u);
            else XB_SPIN(xb_ld(&bar[XB_TOPGEN]) == tg, bar);
            __builtin_amdgcn_fence(__ATOMIC_ACQUIRE, "agent");
            xb_add(&bar[XB_XGEN(b.x)], 1u);
            asm volatile("s_waitcnt vmcnt(0)" ::: "memory");
        } else {
            XB_SPIN(xb_ld(&bar[XB_XGEN(b.x)]) == gen, bar);
            __builtin_amdgcn_fence(__ATOMIC_ACQUIRE, "agent");
            asm volatile("s_waitcnt vmcnt(0)" ::: "memory");
        }
    }
    __syncthreads();
}
typedef float f32x2v __attribute__((ext_vector_type(2)));
typedef unsigned u32x2v __attribute__((ext_vector_type(2)));
typedef int i32x4 __attribute__((ext_vector_type(4)));
typedef int i32x8g __attribute__((ext_vector_type(8)));
#define H6S(x_) __builtin_amdgcn_fmed3f((x_) * 2.0f, -7.5f, 7.5f)
typedef __bf16 bf16x2_t __attribute__((ext_vector_type(2)));
__device__ __forceinline__ float bf_lo_(unsigned w) { return __builtin_bit_cast(float, w << 16); }
__device__ __forceinline__ float bf_hi_(unsigned w) { return __builtin_bit_cast(float, w & 0xffff0000u); }
struct Frame {
    LAS unsigned char* lds;
    volatile LAS unsigned* MISC;
    gu32* ctl;
    int wave;
    int vcu, G;
    unsigned char* ws;
};
__device__ __forceinline__ int tid_() { return (int)threadIdx.x; }
__device__ __forceinline__ int lane_() { return (int)(threadIdx.x & 63u); }
__device__ __forceinline__ float wave_sum(float v) {
#pragma unroll
    for (int o = 1; o < 64; o <<= 1) v += __shfl_xor(v, o);
    return v;
}
__device__ __forceinline__ int win_dest_row(int c) {
    const bool rope = (c < 3072) || (c >= 4608 && c < 5888);
    const int d = c & 127; const int pp = (((d & 63) >> 2) << 3) + ((d >> 6) << 2) + (d & 3);
    return rope ? ((c & ~127) + pp) : c;
}
template <bool WIN_MAP>
__device__ __forceinline__ void p0_transpose_item(const float* W, int K, int N, bf16* WT, int row_off, LAS float* scr, int item, int lane) {
    const int nblk = N / 32, kb = item / nblk, nb = item % nblk, k0 = 64 * kb, n0 = 32 * nb;
    float wv_[32];
#pragma unroll
    for (int i = 0; i < 32; ++i) wv_[i] = W[(size_t)(k0 + 2 * i + (lane >> 5)) * N + n0 + (lane & 31)];
#pragma unroll
    for (int i = 0; i < 32; ++i) scr[(2 * i + (lane >> 5)) * 33 + (lane & 31)] = wv_[i];
    LDS_WAIT(); asm volatile("" ::: "memory");
    const int c = lane & 7;
#pragma unroll
    for (int j = 0; j < 4; ++j) { const int n = (lane >> 3) + 8 * j; const LAS float* s = scr + (8 * c) * 33 + n;
        v4u o; o.x = pk2(s[0 * 33], s[1 * 33]); o.y = pk2(s[2 * 33], s[3 * 33]); o.z = pk2(s[4 * 33], s[5 * 33]); o.w = pk2(s[6 * 33], s[7 * 33]);
        const int drow = WIN_MAP ? win_dest_row(n0 + n) : (row_off + n0 + n);
        *(GAS v4u*)(WT + (size_t)drow * K + k0 + 8 * c) = o; }
    LDS_WAIT(); asm volatile("" ::: "memory");
}
template <bool WIN_MAP>
__device__ __forceinline__ void p0_transpose_item8(const float* W, int K, int N, unsigned char* WT, LAS float* scr, int item, int lane, float sc) {
    const int nblk = N / 32, kb = item / nblk, nb = item % nblk, k0 = 64 * kb, n0 = 32 * nb;
    float wv_[32];
#pragma unroll
    for (int i = 0; i < 32; ++i) wv_[i] = W[(size_t)(k0 + 2 * i + (lane >> 5)) * N + n0 + (lane & 31)];
#pragma unroll
    for (int i = 0; i < 32; ++i) scr[(2 * i + (lane >> 5)) * 33 + (lane & 31)] = wv_[i] * sc;
    LDS_WAIT(); asm volatile("" ::: "memory");
    const int c = lane & 7;
#pragma unroll
    for (int j = 0; j < 4; ++j) { const int n = (lane >> 3) + 8 * j; const LAS float* sp_ = scr + (8 * c) * 33 + n;
        int w0 = 0, w1 = 0;
        w0 = CVT2_FP8(sp_[0 * 33], sp_[1 * 33], w0, false); w0 = CVT2_FP8(sp_[2 * 33], sp_[3 * 33], w0, true);
        w1 = CVT2_FP8(sp_[4 * 33], sp_[5 * 33], w1, false); w1 = CVT2_FP8(sp_[6 * 33], sp_[7 * 33], w1, true);
        *(GAS u32x2v*)(WT + (size_t)(WIN_MAP ? win_dest_row(n0 + n) : (n0 + n)) * K + k0 + 8 * c) = (u32x2v){(unsigned)w0, (unsigned)w1}; }
    LDS_WAIT(); asm volatile("" ::: "memory");
}
__device__ __forceinline__ void cvt_copy_fp8(Frame& F, const float* src, unsigned char* dst, size_t n, float sc) {
    const size_t nthr = (size_t)F.G * NWAVES * 64, gt = (size_t)F.vcu * NWAVES * 64 + tid_();
    for (size_t i = gt; i < n / 16; i += nthr) { f32x4 a[4];
#pragma unroll
        for (int j = 0; j < 4; ++j) a[j] = *(const GAS f32x4*)(src + i * 16 + j * 4) * sc;
        v4u o;
#pragma unroll
        for (int j = 0; j < 4; ++j) { int w = 0; w = CVT2_FP8(a[j].x, a[j].y, w, false); w = CVT2_FP8(a[j].z, a[j].w, w, true); o[j] = (unsigned)w; }
        *(GAS v4u*)(dst + i * 16) = o; }
}
__device__ __forceinline__ void cvt_copy(Frame& F, const float* src, bf16* dst, size_t n) {
    const size_t nthr = (size_t)F.G * NWAVES * 64, gt = (size_t)F.vcu * NWAVES * 64 + tid_();
    size_t i = gt;
    for (; i + 3 * nthr < n / 8; i += 4 * nthr) {
        f32x4 a[4], b[4];
#pragma unroll
        for (int u = 0; u < 4; ++u) { a[u] = *(const GAS f32x4*)(src + (i + u * nthr) * 8); b[u] = *(const GAS f32x4*)(src + (i + u * nthr) * 8 + 4); }
#pragma unroll
        for (int u = 0; u < 4; ++u) { v4u o; o.x = pk2(a[u].x, a[u].y); o.y = pk2(a[u].z, a[u].w); o.z = pk2(b[u].x, b[u].y); o.w = pk2(b[u].z, b[u].w); *(GAS v4u*)(dst + (i + u * nthr) * 8) = o; }
    }
    for (; i < n / 8; i += nthr) { const f32x4 a = *(const GAS f32x4*)(src + i * 8), b = *(const GAS f32x4*)(src + i * 8 + 4);
        v4u o; o.x = pk2(a.x, a.y); o.y = pk2(a.z, a.w); o.z = pk2(b.x, b.y); o.w = pk2(b.z, b.w); *(GAS v4u*)(dst + i * 8) = o; }
}
typedef float f32x2g __attribute__((ext_vector_type(2)));
typedef _Float16 f16x2g __attribute__((ext_vector_type(2)));
typedef float f32x16t __attribute__((ext_vector_type(16)));
typedef float f32x32t __attribute__((ext_vector_type(32)));
typedef unsigned u32x6t __attribute__((ext_vector_type(6)));
typedef unsigned u32x16t __attribute__((ext_vector_type(16)));
typedef unsigned u32x3t __attribute__((ext_vector_type(3)));
__device__ __forceinline__ void cvt_copy_fp6(Frame& F, const float* src, unsigned char* dst, int rows, float sc) {
    const size_t nthr = (size_t)F.G * NWAVES * 64, gt = (size_t)F.vcu * NWAVES * 64 + tid_();
    for (size_t i = gt; i < (size_t)rows * 64; i += nthr) { const size_t row = i >> 6; const int L = (int)(i & 63);
        f32x16t a, b;
#pragma unroll
        for (int c = 0; c < 2; ++c)
#pragma unroll
            for (int j = 0; j < 4; ++j) { const f32x4 v = *(const GAS f32x4*)(src + row * 2048 + c * 1024 + 16 * L + 4 * j) * sc;
                a[8 * c + 2 * j] = v.x; b[8 * c + 2 * j] = v.y; a[8 * c + 2 * j + 1] = v.z; b[8 * c + 2 * j + 1] = v.w; }
        const u32x6t w = __builtin_amdgcn_cvt_scalef32_2xpk16_fp6_f32(a, b, 1.0f);
        unsigned char* rp = dst + row * 1536 + L * 12;
        *(GAS u32x3t*)rp = (u32x3t){w[0], w[1], w[2]}; *(GAS u32x3t*)(rp + 768) = (u32x3t){w[3], w[4], w[5]}; }
}
__device__ __forceinline__ void cvt_copy_fp4(Frame& F, const float* src, unsigned char* dst, int rows, float sc) {
    const size_t nthr = (size_t)F.G * NWAVES * 64, gt = (size_t)F.vcu * NWAVES * 64 + tid_();
    for (size_t i = gt; i < (size_t)rows * 64; i += nthr) { const size_t row = i >> 6; const int L = (int)(i & 63);
        v4u o;
#pragma unroll
        for (int d = 0; d < 4; ++d) { const f32x4 a = *(const GAS f32x4*)(src + row * 2048 + (d >> 1) * 1024 + 16 * L + (d & 1) * 8) * sc, b = *(const GAS f32x4*)(src + row * 2048 + (d >> 1) * 1024 + 16 * L + (d & 1) * 8 + 4) * sc;
            unsigned w = 0;
            w = __builtin_amdgcn_cvt_scalef32_pk_fp4_f32(w, a.x, a.y, 1.0f, 0); w = __builtin_amdgcn_cvt_scalef32_pk_fp4_f32(w, a.z, a.w, 1.0f, 1);
            w = __builtin_amdgcn_cvt_scalef32_pk_fp4_f32(w, b.x, b.y, 1.0f, 2); w = __builtin_amdgcn_cvt_scalef32_pk_fp4_f32(w, b.z, b.w, 1.0f, 3); o[d] = w;
            }
        *(GAS v4u*)(dst + row * 1024 + L * 16) = o; }
}
__device__ __forceinline__ void p0_prologue(Frame& F, const float* x, const float* p, const float* w_in, const float* wba, const float* wbb, const float* w_out, const float* wq, const float* subkeys, const float* ple_gate, const float* ple_proj) {
    const int lane = lane_();
    LAS float* scr = (LAS float*)(F.lds + RING_OFF + F.wave * 16384);
    const int gw = F.vcu * NWAVES + F.wave, NGW = F.G * NWAVES;
    bf16* WIN = (bf16*)(F.ws + WS_WIN); bf16* WBA = (bf16*)(F.ws + WS_WBA); bf16* WBB = (bf16*)(F.ws + WS_WBB); bf16* WOUT = (bf16*)(F.ws + WS_WOUT);
    bf16* WQG = (bf16*)(F.ws + WS_WQG); bf16* WPP = (bf16*)(F.ws + WS_WPP);
    constexpr int I_IN = (D / 64) * (IN_COLS / 32), I_BA = (512 / 64) * (D / 32), I_BB = (1024 / 64) * (D / 32), I_SQ = (D / 64) * (D / 32), I_PP = (256 / 64) * (D / 32);
    constexpr int NITEMS = I_IN + I_BA + I_BB + 3 * I_SQ + I_PP;
    for (int it = gw; it < NITEMS; it += NGW) {
        int r = it;
        if (r < I_IN) { p0_transpose_item8<true>(w_in, D, IN_COLS, (unsigned char*)WIN, scr, r, lane, 1024.0f); continue; } r -= I_IN;
        if (r < I_BA) { p0_transpose_item8<false>(wba, 512, D, (unsigned char*)WBA, scr, r, lane, 256.0f); continue; } r -= I_BA;
        if (r < I_BB) { p0_transpose_item8<false>(wbb, 1024, D, (unsigned char*)WBB, scr, r, lane, 512.0f); continue; } r -= I_BB;
        if (r < I_SQ) { p0_transpose_item8<false>(w_out, D, D, (unsigned char*)WOUT, scr, r, lane, 2048.0f); continue; } r -= I_SQ;
        if (r < I_SQ) { p0_transpose_item<false>(wq, D, D, WQG, 0, scr, r, lane); continue; } r -= I_SQ;
        if (r < I_SQ) { p0_transpose_item8<false>(ple_gate, D, D, (unsigned char*)WQG + (size_t)8 * MiB, scr, r, lane, 1024.0f); continue; } r -= I_SQ;
        p0_transpose_item<false>(ple_proj, 256, D, WPP, 0, scr, r, lane);
    }
    cvt_copy_fp8(F, x, F.ws + WS_XB, (size_t)T * D, 32.0f);
    cvt_copy(F, p, (bf16*)(F.ws + WS_PB), (size_t)T * 256);
    cvt_copy(F, subkeys, (bf16*)(F.ws + WS_SK), (size_t)8 * 2 * 128 * 128);
    { float* COS = (float*)(F.ws + WS_COS); float* SIN = (float*)(F.ws + WS_SIN);
      const int nthr = F.G * NWAVES * 64, gt = F.vcu * NWAVES * 64 + tid_();
      for (int e = gt; e < S * 64; e += nthr) { const int pos = e >> 6, i = e & 63;
          const float inv = 1.0f / powf(10000.0f, (float)(2 * i) * (1.0f / 128.0f));
          const float ang = (float)pos * inv; COS[e] = cosf(ang); SIN[e] = sinf(ang); } }
}
typedef float f32x16 __attribute__((ext_vector_type(16)));
typedef unsigned u32x4t __attribute__((ext_vector_type(4)));
__device__ __forceinline__ int crow(int r, int hi) { return (r & 3) + 8 * (r >> 2) + 4 * hi; }
typedef short v4i16_t __attribute__((ext_vector_type(4)));
__device__ __forceinline__ void glds16(const void* gsrc, unsigned lds_dst);
__device__ __forceinline__ void attn_tile(const bf16* Qh, const bf16* Kh, const bf16* Vh, int R0, int Lsub, int maxd, bool isB, float sink,
                                          bf16* Orow0, int o_pitch, int o_tokstride  , float* MLrow0, int lane,
                                          LAS unsigned char* vbuf  ) {
    const int c = lane & 31, hi = lane >> 5;
    const int n0 = R0 & (Lsub - 1), rbase = R0 - n0;
    constexpr float C = 0.08838834764831845f * 1.4426950408889634f;
    const unsigned vb0 = (unsigned)(uintptr_t)vbuf;
    const int drow = lane >> 4, dunit = (lane & 15) ^ (drow << 2);
#define V_DMA(kt_) do { const bf16* vsrc_ = Vh + (size_t)(rbase + n0 - 128 + 32 * (kt_) + drow) * 128 + dunit * 8; const unsigned vd_ = vb0 + (unsigned)(((kt_) & 1) * 8192); \
        _Pragma("unroll") for (int pc_ = 0; pc_ < 8; ++pc_) glds16(vsrc_ + (size_t)pc_ * 4 * 128, vd_ + (unsigned)pc_ * 1024u); } while (0)
#define K_DMA(kt_) do { const unsigned kd_ = vb0 + (unsigned)(((kt_) & 1) * 8192); \
        _Pragma("unroll") for (int pc_ = 0; pc_ < 8; ++pc_) { const int row_ = 4 * pc_ + drow; glds16(Kh + (size_t)(rbase + n0 - 128 + 32 * (kt_) + row_) * 128 + (((lane & 15) ^ (row_ & 15)) * 8), kd_ + (unsigned)pc_ * 1024u); } } while (0)
    bf16x8 qf[8];
#pragma unroll
    for (int s = 0; s < 8; ++s) qf[s] = *(const GAS bf16x8*)(Qh + (size_t)(R0 + c) * 128 + 16 * s + 8 * hi);
    asm volatile("s_waitcnt lgkmcnt(0)" ::: "memory");
    const int kt0 = (n0 >= 128) ? 0 : (4 - (n0 >> 5));
    K_DMA(kt0); if (kt0 < 4) K_DMA(kt0 + 1);
    f32x16 sc[5];
    const float NEG = -__builtin_inff();
    const LAS unsigned char* kbase = vbuf + c * 256; const int kx = c & 15;
#pragma unroll
    for (int kt = 0; kt < 5; ++kt) {
        const int nk = n0 - 128 + 32 * kt;
        if (nk >= 0) {
            if (kt < 4 || n0 >= 32) asm volatile("s_waitcnt vmcnt(8)" ::: "memory"); else asm volatile("s_waitcnt vmcnt(0)" ::: "memory");
            const LAS unsigned char* kb = kbase + (kt & 1) * 8192;
            bf16x8 kf[8];
#pragma unroll
            for (int s = 0; s < 8; ++s) kf[s] = *(const LAS bf16x8*)(kb + (((2 * s + hi) ^ kx) << 4));
            asm volatile("s_waitcnt lgkmcnt(0)" ::: "memory");
            if (kt + 2 <= 4) K_DMA(kt + 2);
            else if (kt == 3) { V_DMA(3); }
            else { V_DMA(4); }
            f32x16 a = {};
#pragma unroll
            for (int s = 0; s < 8; ++s) a = __builtin_amdgcn_mfma_f32_32x32x16_bf16(kf[s], qf[s], a, 0, 0, 0);
            if (kt == 0) {
#pragma unroll
                for (int r = 0; r < 16; ++r) { const int dist = 128 + c - crow(r, hi); if (dist > maxd) a[r] = NEG; }
            }
            if (kt == 4) {
#pragma unroll
                for (int r = 0; r < 16; ++r) { if (crow(r, hi) > c) a[r] = NEG; }
            }
            sc[kt] = a;
        } else {
#pragma unroll
            for (int r = 0; r < 16; ++r) sc[kt][r] = NEG;
        }
    }
#undef K_DMA
    float mx = NEG;
#pragma unroll
    for (int kt = 0; kt < 5; ++kt)
#pragma unroll
        for (int r = 0; r < 16; ++r) mx = fmaxf(mx, sc[kt][r]);
    mx = fmaxf(mx, __shfl_xor(mx, 32));
    float mt = mx * C;
    const float sink_t = sink * 1.4426950408889634f;
    if (isB) mt = fmaxf(mt, sink_t);
    float l = 0.f;
#pragma unroll
    for (int kt = 0; kt < 5; ++kt)
#pragma unroll
        for (int r = 0; r < 16; ++r) { const float pv = __builtin_amdgcn_exp2f(sc[kt][r] * C - mt); sc[kt][r] = pv; l += pv; }
    l += __shfl_xor(l, 32);
    const float denom = isB ? (l + __builtin_amdgcn_exp2f(sink_t - mt)) : l;
    const float inv = 1.0f / denom;
    f32x16 o[4];
#pragma unroll
    for (int e = 0; e < 4; ++e) o[e] = (f32x16){};
    const int tq = (lane & 15) >> 2, tp = lane & 3, tg = (lane >> 4) & 1;
    const LAS unsigned char* tbase = vbuf + (4 * hi + tq) * 256 + (2 * tg + (tp >> 1)) * 16 + 8 * (tp & 1);
#pragma unroll
    for (int it = 0; it < 5; ++it) {
        const int kt = 4 - it; const int nk = n0 - 128 + 32 * kt;
        if (nk >= 0) {
            const bool more = (kt >= 2) && (nk - 64 >= 0);
            const bool nxt = (kt >= 1) && (nk - 32 >= 0);
            if (nxt && kt != 4) asm volatile("s_waitcnt vmcnt(8)" ::: "memory"); else asm volatile("s_waitcnt vmcnt(0)" ::: "memory");
            const LAS unsigned char* tb = tbase + (kt & 1) * 8192;
            bf16x8 pk[2];
#pragma unroll
            for (int s = 0; s < 2; ++s) { u32x4t w; w.x = pg8::cvt_pk_bf16(sc[kt][8 * s + 0], sc[kt][8 * s + 1]); w.y = pg8::cvt_pk_bf16(sc[kt][8 * s + 2], sc[kt][8 * s + 3]);
                w.z = pg8::cvt_pk_bf16(sc[kt][8 * s + 4], sc[kt][8 * s + 5]); w.w = pg8::cvt_pk_bf16(sc[kt][8 * s + 6], sc[kt][8 * s + 7]); pk[s] = __builtin_bit_cast(bf16x8, w); }
#pragma unroll
            for (int e = 0; e < 4; ++e)
#pragma unroll
                for (int s = 0; s < 2; ++s) {
                    const LAS unsigned char* ap = tb + s * 4096 + ((e ^ tq) << 6);
                    const v4i16_t lo = __builtin_amdgcn_ds_read_tr16_b64_v4i16((LAS v4i16_t*)ap), hi4 = __builtin_amdgcn_ds_read_tr16_b64_v4i16((LAS v4i16_t*)(ap + 2048));
                    const bf16x8 vf = {lo[0], lo[1], lo[2], lo[3], hi4[0], hi4[1], hi4[2], hi4[3]};
                    o[e] = __builtin_amdgcn_mfma_f32_32x32x16_bf16(vf, pk[s], o[e], 0, 0, 0);
                }
            asm volatile("s_waitcnt lgkmcnt(0)" ::: "memory");
            if (more) V_DMA(kt - 2);
        }
    }
#undef V_DMA
#pragma unroll
    for (int e = 0; e < 4; ++e)
#pragma unroll
        for (int g4 = 0; g4 < 4; ++g4) {
            if (isB) { const float sc8 = inv * 32.0f; int w8 = 0;
                w8 = CVT2_FP8(o[e][4 * g4] * sc8, o[e][4 * g4 + 1] * sc8, w8, false); w8 = CVT2_FP8(o[e][4 * g4 + 2] * sc8, o[e][4 * g4 + 3] * sc8, w8, true);
                *(GAS unsigned*)((unsigned char*)Orow0 + (size_t)c * o_tokstride * o_pitch + 32 * e + 8 * g4 + 4 * hi) = (unsigned)w8; }
            else { u32x2v w; w.x = pk2(o[e][4 * g4] * inv, o[e][4 * g4 + 1] * inv); w.y = pk2(o[e][4 * g4 + 2] * inv, o[e][4 * g4 + 3] * inv);
                *(GAS u32x2v*)(Orow0 + (size_t)c * o_tokstride * o_pitch + 32 * e + 8 * g4 + 4 * hi) = w; } }
    if (!isB && hi == 0) { f32x2v ml; ml.x = mt; ml.y = l; *(GAS f32x2v*)(MLrow0 + (size_t)c * o_tokstride * 8) = ml; }
}
__device__ __forceinline__ void p2_attention(Frame& F, const float* sinks) {
    const bf16* QA = (const bf16*)(F.ws + WS_QA); const bf16* KA = (const bf16*)(F.ws + WS_KA); const bf16* VA = (const bf16*)(F.ws + WS_VA);
    const bf16* QB = (const bf16*)(F.ws + WS_QB); const bf16* KB = (const bf16*)(F.ws + WS_KB); const bf16* VB = (const bf16*)(F.ws + WS_VB);
    bf16* OG = (bf16*)(F.ws + WS_OG); bf16* OB = (bf16*)(F.ws + WS_OB); float* ML = (float*)(F.ws + WS_ML);
    const int gw = F.vcu * NWAVES + F.wave, NGW = F.G * NWAVES;
    constexpr int NTA = NB * 12 * 128, NTB = NB * 8 * 128, NTT = NTA + NTB;
    const int per = (NTT + NGW - 1) / NGW;
    for (int i = 0; i < per; ++i) {
        const int tile = i * NGW + gw; if (tile >= NTT) continue;
        if (tile < NTA) {
            const int th = tile & 127, bj = tile >> 7, j = bj % 12, b = bj / 12, g = j >> 2, hh = j & 3, dsh = 2 * g, Lsub = S >> dsh, R0 = th * 32;
            const int res = R0 >> (12 - dsh), n0 = R0 & (Lsub - 1);
            const size_t hb = (size_t)(b * 12 + j) * S * 128;
            const size_t tok0 = (size_t)b * S + ((size_t)n0 << dsh) + res;
            attn_tile(QA + hb, KA + hb, VA + hb, R0, Lsub, 128, false, 0.f,
                      OG + ((size_t)g * T + tok0) * 512 + hh * 128, 512, 1 << dsh, ML + (((size_t)g * T + tok0) * 4 + hh) * 2, lane_(), F.lds + RING_OFF + F.wave * 16384);
        } else {
            const int t2 = tile - NTA, j = ((t2 >> 9) & 1) * 4 + (t2 & 3), th = ((t2 >> 3) & 63) * 2 + ((t2 >> 2) & 1), b = t2 >> 10, R0 = th * 32;
            const size_t hq = (size_t)(b * 8 + j) * S * 128, hk = (size_t)(b * 2 + (j >> 2)) * S * 128;
            const size_t tok0 = (size_t)b * S + R0;
            attn_tile(QB + hq, KB + hk, VB + hk, R0, S, 127, true, sinks[j],
                      (bf16*)((unsigned char*)OB + tok0 * 1024 + j * 128), 1024, 1, nullptr, lane_(), F.lds + RING_OFF + F.wave * 16384);
        }
    }
    asm volatile("s_waitcnt vmcnt(0) lgkmcnt(0)" ::: "memory");
}
__device__ __forceinline__ void p3_combine(Frame& F, const float* peer_u, const float* peer_v) {
    const bf16* OG = (const bf16*)(F.ws + WS_OG); const float* ML = (const float*)(F.ws + WS_ML); bf16* OA = (bf16*)(F.ws + WS_OA);
    const int gw = F.vcu * NWAVES + F.wave, NGW = F.G * NWAVES, lane = lane_();
    const int hh = lane >> 4;
    for (int tok = gw; tok < T; tok += NGW) {
        float m[3], l[3];
#pragma unroll
        for (int g = 0; g < 3; ++g) { const f32x2v v = *(const GAS f32x2v*)(ML + (((size_t)g * T + tok) * 4 + hh) * 2); m[g] = v.x; l[g] = v.y; }
        const float M = fmaxf(fmaxf(m[0], m[1]), m[2]);
        float w[3], ws = 0.f;
#pragma unroll
        for (int g = 0; g < 3; ++g) { w[g] = l[g] * __builtin_amdgcn_exp2f(m[g] - M); ws += w[g]; }
        const float iw = 1.0f / ws;
        f32x4 a0 = {0.f, 0.f, 0.f, 0.f}, a1 = {0.f, 0.f, 0.f, 0.f};
#pragma unroll
        for (int g = 0; g < 3; ++g) { const v4u v = *(const GAS v4u*)(OG + ((size_t)g * T + tok) * 512 + lane * 8); const float wg = w[g] * iw;
            a0 += wg * (f32x4){bf_lo_(v.x), bf_hi_(v.x), bf_lo_(v.y), bf_hi_(v.y)}; a1 += wg * (f32x4){bf_lo_(v.z), bf_hi_(v.z), bf_lo_(v.w), bf_hi_(v.w)}; }
        a0 *= 32.0f; a1 *= 32.0f; int w0 = 0, w1 = 0;
        w0 = CVT2_FP8(a0.x, a0.y, w0, false); w0 = CVT2_FP8(a0.z, a0.w, w0, true);
        w1 = CVT2_FP8(a1.x, a1.y, w1, false); w1 = CVT2_FP8(a1.z, a1.w, w1, true);
        *(GAS u32x2v*)((unsigned char*)OA + (size_t)tok * 512 + lane * 8) = (u32x2v){(unsigned)w0, (unsigned)w1};
    }
}
__device__ __forceinline__ void p7_ln1(Frame& F, const float* ln1_g, const float* ln1_b) {
    const bf16* Y1 = (const bf16*)(F.ws + WS_H1); bf16* H1B = (bf16*)(F.ws + WS_H1B);
    const int gw = F.vcu * NWAVES + F.wave, NGW = F.G * NWAVES, lane = lane_();
    for (int m = gw; m < T; m += NGW) {
        float v[32]; float s = 0.f;
#pragma unroll
        for (int j = 0; j < 4; ++j) { const v4u w = *(const GAS v4u*)(Y1 + (size_t)m * D + j * 512 + lane * 8);
            v[j * 8 + 0] = bf_lo_(w.x); v[j * 8 + 1] = bf_hi_(w.x); v[j * 8 + 2] = bf_lo_(w.y); v[j * 8 + 3] = bf_hi_(w.y); v[j * 8 + 4] = bf_lo_(w.z); v[j * 8 + 5] = bf_hi_(w.z); v[j * 8 + 6] = bf_lo_(w.w); v[j * 8 + 7] = bf_hi_(w.w); }
#pragma unroll
        for (int i = 0; i < 32; ++i) s += v[i];
        const float mean = wave_sum(s) * (1.f / D); float s2 = 0.f;
#pragma unroll
        for (int i = 0; i < 32; ++i) { v[i] -= mean; s2 += v[i] * v[i]; }
        const float rstd = 1.f / sqrtf(wave_sum(s2) * (1.f / D) + LN_EPS);
#pragma unroll
        for (int j = 0; j < 4; ++j) { const int col = j * 512 + lane * 8;
            const f32x4 g0 = *(const GAS f32x4*)(ln1_g + col), g1 = *(const GAS f32x4*)(ln1_g + col + 4), b0 = *(const GAS f32x4*)(ln1_b + col), b1 = *(const GAS f32x4*)(ln1_b + col + 4);
            v4u o; o.x = pk2(v[j * 8 + 0] * rstd * g0.x + b0.x, v[j * 8 + 1] * rstd * g0.y + b0.y); o.y = pk2(v[j * 8 + 2] * rstd * g0.z + b0.z, v[j * 8 + 3] * rstd * g0.w + b0.w);
            o.z = pk2(v[j * 8 + 4] * rstd * g1.x + b1.x, v[j * 8 + 5] * rstd * g1.y + b1.y); o.w = pk2(v[j * 8 + 6] * rstd * g1.z + b1.z, v[j * 8 + 7] * rstd * g1.w + b1.w);
            *(GAS v4u*)(H1B + (size_t)m * D + col) = o;
            { int w0 = 0, w1 = 0;
              w0 = CVT2_FP8(bf_lo_(o.x) * 32.f, bf_hi_(o.x) * 32.f, w0, false); w0 = CVT2_FP8(bf_lo_(o.y) * 32.f, bf_hi_(o.y) * 32.f, w0, true);
              w1 = CVT2_FP8(bf_lo_(o.z) * 32.f, bf_hi_(o.z) * 32.f, w1, false); w1 = CVT2_FP8(bf_lo_(o.w) * 32.f, bf_hi_(o.w) * 32.f, w1, true);
              *(GAS u32x2v*)(F.ws + WS_H1F8 + (size_t)m * D + col) = (u32x2v){(unsigned)w0, (unsigned)w1}; } }
    }
}
__device__ __forceinline__ unsigned f2ord(float f) { const unsigned u = __builtin_bit_cast(unsigned, f); return (u & 0x80000000u) ? ~u : (u | 0x80000000u); }
__device__ __forceinline__ float ord2f(unsigned o) { const unsigned u = (o & 0x80000000u) ? (o ^ 0x80000000u) : ~o; return __builtin_bit_cast(float, u); }
__device__ __forceinline__ unsigned umax_(unsigned a, unsigned b) { return a > b ? a : b; }
__device__ __forceinline__ unsigned umin_(unsigned a, unsigned b) { return a < b ? a : b; }
template <int N> __device__ __forceinline__ void bitonic_sort_desc(unsigned (&v)[N]) {
#pragma unroll
    for (int k = 2; k <= N; k <<= 1)
#pragma unroll
        for (int j = k >> 1; j > 0; j >>= 1)
#pragma unroll
            for (int i = 0; i < N; ++i) { const int l = i ^ j;
                if (l > i) { const unsigned a = v[i], b = v[l], mx = umax_(a, b), mn = umin_(a, b); const bool desc = ((i & k) == 0); v[i] = desc ? mx : mn; v[l] = desc ? mn : mx; } }
}
template <int N> __device__ __forceinline__ void bitonic_merge_desc(unsigned (&v)[N]) {
#pragma unroll
    for (int j = N >> 1; j > 0; j >>= 1)
#pragma unroll
        for (int i = 0; i < N; ++i) { const int l = i ^ j;
            if (l > i) { const unsigned a = v[i], b = v[l]; v[i] = umax_(a, b); v[l] = umin_(a, b); } }
}
__device__ __forceinline__ void top16_of_64(const unsigned (&v)[64], unsigned (&w)[16]) {
    unsigned q[4][16];
#pragma unroll
    for (int g = 0; g < 4; ++g) {
#pragma unroll
        for (int i = 0; i < 16; ++i) q[g][i] = v[16 * g + i];
        bitonic_sort_desc<16>(q[g]); }
#pragma unroll
    for (int i = 0; i < 16; ++i) { q[0][i] = umax_(q[0][i], q[1][15 - i]); q[2][i] = umax_(q[2][i], q[3][15 - i]); }
    bitonic_merge_desc<16>(q[0]); bitonic_merge_desc<16>(q[2]);
#pragma unroll
    for (int i = 0; i < 16; ++i) w[i] = umax_(q[0][i], q[2][15 - i]);
    bitonic_merge_desc<16>(w);
}
__host__ __device__ constexpr int cand_ok(int i, int j) { return (i + 1) * (j + 1) <= 16; }
__host__ __device__ constexpr int cand_index(int i, int j) { int n = 0; for (int a = 0; a < 16; ++a) for (int b = 0; b < 16; ++b) { if (a == i && b == j) return n; if (cand_ok(a, b)) ++n; } return n; }
__device__ __forceinline__ void route_half(const bf16* Q, const bf16* SK, int tok0, int h, int c, int lane, unsigned (&top)[16]) {
    const int cl = lane & 31, hi = lane >> 5;
    bf16x8 qf[8];
#pragma unroll
    for (int s = 0; s < 8; ++s) qf[s] = *(const GAS bf16x8*)(Q + (size_t)(tok0 + cl) * 2048 + h * 256 + c * 128 + 16 * s + 8 * hi);
    unsigned v[64];
#pragma unroll
    for (int nt = 0; nt < 4; ++nt) {
        const bf16* kp = SK + (size_t)((h * 2 + c) * 128 + nt * 32 + cl) * 128 + 8 * hi;
        f32x16 a = {};
#pragma unroll
        for (int s = 0; s < 8; ++s) { const bf16x8 kf = *(const GAS bf16x8*)(kp + 16 * s); a = __builtin_amdgcn_mfma_f32_32x32x16_bf16(kf, qf[s], a, 0, 0, 0); }
#pragma unroll
        for (int r = 0; r < 16; ++r) { const int n = nt * 32 + crow(r, hi); v[nt * 16 + r] = (f2ord(a[r]) & ~127u) | (unsigned)(127 - n); }
        asm volatile("" ::: "memory");
    }
    unsigned w0[16]; top16_of_64(v, w0);
    unsigned w[16];
#pragma unroll
    for (int i = 0; i < 16; ++i) { const unsigned pv = (unsigned)__shfl_xor((int)w0[15 - i], 32); w[i] = umax_(w0[i], pv); }
    bitonic_merge_desc<16>(w);
#pragma unroll
    for (int i = 0; i < 16; ++i) top[i] = w[i];
}
__device__ __forceinline__ void p9_route(Frame& F) {
    const bf16* Q = (const bf16*)(F.ws + WS_Q); const bf16* SK = (const bf16*)(F.ws + WS_SK);
    int* IDX = (int*)(F.ws + WS_IDX); float* GATE = (float*)(F.ws + WS_GATE);
    const int gw = F.vcu * NWAVES + F.wave, NGW = F.G * NWAVES;
    LAS unsigned* sidx = (LAS unsigned*)(F.lds + RING_OFF + F.wave * 8192);
    constexpr int NUNIT = (T / 32) * 8;
    for (int unit = gw; unit < NUNIT; unit += NGW) {
        int lane = lane_(); asm volatile("" : "+v"(lane)); const int cl = lane & 31, hi = lane >> 5;
        const int h = (unit >> 3) & 7, tt = ((unit >> 6) << 3) | (unit & 7), tok0 = tt * 32;
        unsigned k1[16], k2[16];
        route_half(Q, SK, tok0, h, 0, lane, k1);
        route_half(Q, SK, tok0, h, 1, lane, k2);
        float s1[16], s2[16];
#pragma unroll
        for (int i = 0; i < 16; ++i) { s1[i] = ord2f(k1[i] & ~127u); s2[i] = ord2f(k2[i] & ~127u);
            sidx[(0 * 16 + i) * 64 + lane] = 127u - (k1[i] & 127u); sidx[(1 * 16 + i) * 64 + lane] = 127u - (k2[i] & 127u); }
        unsigned cd[64];
#pragma unroll
        for (int i = 0; i < 64; ++i) cd[i] = 0u;
        constexpr int CN[16] = {16, 8, 5, 4, 3, 2, 2, 2, 1, 1, 1, 1, 1, 1, 1, 1};
        constexpr int CO[16] = {0, 16, 24, 29, 33, 36, 38, 40, 42, 43, 44, 45, 46, 47, 48, 49};
#pragma unroll
        for (int i = 0; i < 16; ++i)
#pragma unroll
            for (int j = 0; j < 16; ++j) if (j < CN[i]) cd[CO[i] + j] = (f2ord(s1[i] + s2[j]) & ~255u) | (unsigned)(255 - (i * 16 + j));
        unsigned ct[16]; top16_of_64(cd, ct);
        float fs[16]; float es = 0.f;
#pragma unroll
        for (int k = 0; k < 16; ++k) fs[k] = ord2f(ct[k] & ~255u);
        const float fm = fs[0];
#pragma unroll
        for (int k = 0; k < 16; ++k) { fs[k] = __expf(fs[k] - fm); es += fs[k]; }
        const float ies = 1.0f / es;
        int ex[16];
#pragma unroll
        for (int k = 0; k < 16; ++k) { const unsigned code = 255u - (ct[k] & 255u); const unsigned e1 = sidx[(0 * 16 + (code >> 4)) * 64 + lane], e2 = sidx[(1 * 16 + (code & 15u)) * 64 + lane];
            ex[k] = (int)(e1 * 128u + e2); fs[k] *= ies; }
        if (hi == 0) {
            GAS int* ip = (GAS int*)(IDX + (size_t)(tok0 + cl) * 128 + h * 16); GAS float* gp = (GAS float*)(GATE + (size_t)(tok0 + cl) * 128 + h * 16);
#pragma unroll
            for (int k = 0; k < 16; k += 4) { *(GAS i32x4*)(ip + k) = (i32x4){ex[k], ex[k + 1], ex[k + 2], ex[k + 3]}; *(GAS f32x4*)(gp + k) = (f32x4){fs[k], fs[k + 1], fs[k + 2], fs[k + 3]}; }
        }
    }
}
__device__ __forceinline__ float dot2_bf16(unsigned w, unsigned x, float acc) { return __builtin_amdgcn_fdot2_f32_bf16(__builtin_bit_cast(bf16x2_t, w), __builtin_bit_cast(bf16x2_t, x), acc, false); }
__device__ __forceinline__ float gelu_erf(float x) { return 0.5f * x * (1.0f + erff(x * 0.70710678118654752f)); }
__device__ __forceinline__ void glds12(const void* gsrc, unsigned lds_dst) { unsigned keep;
    asm volatile("s_mov_b32 %0, m0\n\ts_mov_b32 m0, %2\n\ts_nop 0\n\tglobal_load_lds_dwordx3 %1, off\n\ts_mov_b32 m0, %0" : "=&s"(keep) : "v"(gsrc), "s"(lds_dst) : "memory"); }
__device__ __forceinline__ void glds16(const void* gsrc, unsigned lds_dst) { unsigned keep;
    asm volatile("s_mov_b32 %0, m0\n\ts_mov_b32 m0, %2\n\ts_nop 0\n\tglobal_load_lds_dwordx4 %1, off\n\ts_mov_b32 m0, %0" : "=&s"(keep) : "v"(gsrc), "s"(lds_dst) : "memory"); }
__device__ __forceinline__ void p10_gather(Frame& F, const float* ln2_g, const float* ln2_b, float* out) {
    const bf16* H1B = (const bf16*)(F.ws + WS_H1B); const bf16* PLE = (const bf16*)(F.ws + WS_PP);
    const unsigned char* UB = (const unsigned char*)(F.ws + WS_UB); const unsigned char* VT = (const unsigned char*)(F.ws + WS_VT);
    const int* IDX = (const int*)(F.ws + WS_IDX); const float* GATE = (const float*)(F.ws + WS_GATE);
    const int gw = F.vcu * NWAVES + F.wave, NGW = F.G * NWAVES;
    const int per = (T + NGW - 1) / NGW;
    const unsigned ring = (unsigned)(uintptr_t)(F.lds + RING_OFF) + (unsigned)F.wave * 16384u;
    for (int ti = 0; ti < per; ++ti) {
        const int tok = gw * per + ti; if (tok >= T) break;
        int lane = lane_(); asm volatile("" : "+v"(lane));
        const int id0 = IDX[(size_t)tok * 128 + lane], id1 = IDX[(size_t)tok * 128 + 64 + lane];
        const float g0 = GATE[(size_t)tok * 128 + lane], g1 = GATE[(size_t)tok * 128 + 64 + lane];
        unsigned hp[16];
#pragma unroll
        for (int c = 0; c < 2; ++c)
#pragma unroll
            for (int h = 0; h < 2; ++h) { const v4u w = *(const GAS v4u*)(H1B + (size_t)tok * D + c * 1024 + lane * 16 + h * 8); hp[c * 8 + h * 4 + 0] = w.x; hp[c * 8 + h * 4 + 1] = w.y; hp[c * 8 + h * 4 + 2] = w.z; hp[c * 8 + h * 4 + 3] = w.w; }
        float acc[32];
#pragma unroll
        for (int i = 0; i < 32; ++i) acc[i] = 0.f;
        const LAS v4u* rd = (const LAS v4u*)(F.lds + RING_OFF + F.wave * 16384) + lane;
        const unsigned lane12 = (unsigned)lane * 12u, lane16 = (unsigned)lane * 16u;
#define ROW_DMA(hx, q) do { const int hx_ = (hx) > 7 ? 7 : (hx); const int e_ = __builtin_amdgcn_readlane((hx_ < 4) ? id0 : id1, (hx_ & 3) * 16 + ((q) & 15)); \
            const unsigned dst_ = ring + (unsigned)(((q) & 7) * 2048); \
            if ((q) & 16) { glds16(VT + (size_t)e_ * 1024 + lane16, dst_); } \
            else { const unsigned char* src_ = UB + (size_t)e_ * 1536 + lane12; glds12(src_, dst_); glds12(src_ + 768, dst_ + 1024u); } } while (0)
        asm volatile("s_waitcnt vmcnt(0)" ::: "memory");
        ROW_DMA(0, 0); ROW_DMA(0, 1); ROW_DMA(0, 2); ROW_DMA(0, 3); ROW_DMA(0, 4); ROW_DMA(0, 5);
        for (int hd = 0; hd < 8; ++hd) {
            const float gsel = (hd < 4) ? g0 : g1; const int lbase = (hd & 3) * 16;
            float part[16]; float wv = 0.f;
#pragma unroll
            for (int q = 0; q < 32; ++q) {
                if (q + 6 < 32) ROW_DMA(hd, q + 6); else ROW_DMA(hd + 1, q + 6 - 32);
                { int pend = 0;
#pragma unroll
                  for (int r_ = q + 1; r_ <= q + 6; ++r_) pend += ((r_ & 31) < 16) ? 2 : 1;
                  if (pend == 12) asm volatile("s_waitcnt vmcnt(12)" ::: "memory"); else if (pend == 11) asm volatile("s_waitcnt vmcnt(11)" ::: "memory"); else if (pend == 10) asm volatile("s_waitcnt vmcnt(10)" ::: "memory");
                  else if (pend == 9) asm volatile("s_waitcnt vmcnt(9)" ::: "memory"); else if (pend == 8) asm volatile("s_waitcnt vmcnt(8)" ::: "memory"); else if (pend == 7) asm volatile("s_waitcnt vmcnt(7)" ::: "memory");
                  else asm volatile("s_waitcnt vmcnt(6)" ::: "memory"); }
                const v4u r0 = rd[(q & 7) * 128], r1 = rd[(q & 7) * 128 + 64];
                asm volatile("s_waitcnt lgkmcnt(0)" ::: "memory");
                f32x32t f;
                if (q < 16) { }
                else {
#define FP4_BYTE(d_, b_) do { const f32x2g t2 = __builtin_amdgcn_cvt_scalef32_pk_f32_fp4(r0[d_], 1.0f, b_); f[8 * (d_) + 2 * (b_)] = t2.x; f[8 * (d_) + 2 * (b_) + 1] = t2.y; } while (0)
#pragma unroll
                    for (int d = 0; d < 4; ++d) { FP4_BYTE(d, 0); FP4_BYTE(d, 1); FP4_BYTE(d, 2); FP4_BYTE(d, 3); }
#undef FP4_BYTE
                }
                if (q < 16) {
                    const u32x6t w6 = {r0.x, r0.y, r0.z, r1.x, r1.y, r1.z};
                    const u32x16t up = __builtin_bit_cast(u32x16t, __builtin_amdgcn_cvt_scalef32_pk32_bf16_fp6(w6, 1.0f));
                    float a0 = 0.f, a1 = 0.f, a2 = 0.f, a3 = 0.f;
#pragma unroll
                    for (int i = 0; i < 16; i += 4) { a0 = dot2_bf16(up[i], hp[i], a0); a1 = dot2_bf16(up[i + 1], hp[i + 1], a1); a2 = dot2_bf16(up[i + 2], hp[i + 2], a2); a3 = dot2_bf16(up[i + 3], hp[i + 3], a3); }
                    part[q & 15] = (a0 + a1) + (a2 + a3);
                    if (q == 15) {
#pragma unroll
                        for (int st = 8; st >= 1; st >>= 1) { const bool up_ = (lane & st) != 0;
#pragma unroll
                            for (int i = 0; i < st; ++i) { const float send = up_ ? part[i] : part[i + st], keep = up_ ? part[i + st] : part[i]; part[i] = keep + __shfl_xor(send, st); } }
                        float tot = part[0]; tot += __shfl_xor(tot, 16); tot += __shfl_xor(tot, 32);
                        const float gk = __shfl(gsel, lbase + (lane & 15));
                        wv = gk * gelu_erf(tot * (1.0f / 64.0f)) * (1.0f / 5.7f);
                    }
                } else {
                    const float wk = __builtin_bit_cast(float, __builtin_amdgcn_readlane(__builtin_bit_cast(int, wv), q & 15));
#pragma unroll
                    for (int i = 0; i < 32; ++i) acc[i] += wk * f[i];
#pragma unroll
                    for (int c = 0; c < 4; ++c) asm volatile("" : "+v"(acc[c * 8 + 0]), "+v"(acc[c * 8 + 1]), "+v"(acc[c * 8 + 2]), "+v"(acc[c * 8 + 3]), "+v"(acc[c * 8 + 4]), "+v"(acc[c * 8 + 5]), "+v"(acc[c * 8 + 6]), "+v"(acc[c * 8 + 7]));
                }
            }
        }
#undef ROW_DMA
        asm volatile("s_waitcnt vmcnt(0)" ::: "memory");
        float hb[32];
#pragma unroll
        for (int i = 0; i < 16; ++i) { hb[2 * i] = bf_lo_(hp[i]); hb[2 * i + 1] = bf_hi_(hp[i]); }
        float s = 0.f;
#pragma unroll
        for (int c = 0; c < 2; ++c) { const size_t off = (size_t)tok * D + c * 1024 + lane * 16;
#pragma unroll
            for (int h = 0; h < 2; ++h) { const v4u pv = *(const GAS v4u*)(PLE + off + h * 8); const int b0 = c * 16 + h * 8;
                acc[b0 + 0] += DN_ALPHA * hb[b0 + 0] + bf_lo_(pv.x); acc[b0 + 1] += DN_ALPHA * hb[b0 + 1] + bf_hi_(pv.x); acc[b0 + 2] += DN_ALPHA * hb[b0 + 2] + bf_lo_(pv.y); acc[b0 + 3] += DN_ALPHA * hb[b0 + 3] + bf_hi_(pv.y);
                acc[b0 + 4] += DN_ALPHA * hb[b0 + 4] + bf_lo_(pv.z); acc[b0 + 5] += DN_ALPHA * hb[b0 + 5] + bf_hi_(pv.z); acc[b0 + 6] += DN_ALPHA * hb[b0 + 6] + bf_lo_(pv.w); acc[b0 + 7] += DN_ALPHA * hb[b0 + 7] + bf_hi_(pv.w); } }
#pragma unroll
        for (int i = 0; i < 32; ++i) s += acc[i];
        const float mean = wave_sum(s) * (1.f / D); float s2 = 0.f;
#pragma unroll
        for (int i = 0; i < 32; ++i) { acc[i] -= mean; s2 += acc[i] * acc[i]; }
        const float rstd = 1.f / sqrtf(wave_sum(s2) * (1.f / D) + LN_EPS);
#pragma unroll
        for (int c = 0; c < 2; ++c)
#pragma unroll
            for (int j = 0; j < 4; ++j) { const int col = c * 1024 + lane * 16 + j * 4; const size_t off = (size_t)tok * D + col; const int b0 = c * 16 + j * 4;
                const f32x4 ga = *(const GAS f32x4*)(ln2_g + col), ba = *(const GAS f32x4*)(ln2_b + col);
                f32x4 o0; o0.x = acc[b0 + 0] * rstd * ga.x + ba.x; o0.y = acc[b0 + 1] * rstd * ga.y + ba.y; o0.z = acc[b0 + 2] * rstd * ga.z + ba.z; o0.w = acc[b0 + 3] * rstd * ga.w + ba.w;
                *(GAS f32x4*)(out + off) = o0; }
    }
}
__device__ __forceinline__ void sort128(unsigned& a, unsigned& b, int lane) {
#pragma unroll
    for (int k = 2; k <= 128; k <<= 1)
#pragma unroll
        for (int j = k >> 1; j > 0; j >>= 1) {
            if (j == 64) { const unsigned mn = a < b ? a : b, mx = a < b ? b : a; a = mn; b = mx; }
            else { const unsigned pa = (unsigned)__shfl_xor((int)a, j), pb = (unsigned)__shfl_xor((int)b, j);
                const bool lower = (lane & j) == 0; const bool ascA = (k == 128) ? true : ((lane & k) == 0), ascB = (k == 128) ? true : ((k == 64) ? false : ((lane & k) == 0));
                const unsigned amn = a < pa ? a : pa, amx = a < pa ? pa : a, bmn = b < pb ? b : pb, bmx = b < pb ? pb : b;
                a = (lower == ascA) ? amn : amx; b = (lower == ascB) ? bmn : bmx; }
        }
}
__device__ __forceinline__ void p10_gather_sorted(Frame& F, const float* ln2_g, const float* ln2_b, float* out) {
    const bf16* H1B = (const bf16*)(F.ws + WS_H1B); const bf16* PLE = (const bf16*)(F.ws + WS_PP); const unsigned char* H1F8 = F.ws + WS_H1F8;
    const unsigned char* UB = (const unsigned char*)(F.ws + WS_UB); const unsigned char* VT = (const unsigned char*)(F.ws + WS_VT);
    const int* IDX = (const int*)(F.ws + WS_IDX); const float* GATE = (const float*)(F.ws + WS_GATE);
    const int gw = F.vcu * NWAVES + F.wave, NGW = F.G * NWAVES;
    const int per = (T + NGW - 1) / NGW;
    const __amdgpu_buffer_rsrc_t URS = __builtin_amdgcn_make_buffer_rsrc((void*)UB, 0, 0x7fffffff, 0x00020000);
    const unsigned ring = (unsigned)(uintptr_t)(F.lds + RING_OFF) + (unsigned)F.wave * 16384u;
    LAS float* AW = (LAS float*)(F.lds + ACTW_OFF + F.wave * 2048);
    for (int pass = 0; pass < per / 4; ++pass) {
        const int tokb = gw * per + pass * 4; if (tokb + 3 >= T) break;
        int lane = lane_(); asm volatile("" : "+v"(lane));
        const LAS v4u* rd = (const LAS v4u*)(F.lds + RING_OFF + F.wave * 16384) + lane;
        const unsigned lane12 = (unsigned)lane * 12u, lane16 = (unsigned)lane * 16u;
        unsigned key0[4], key1[4];
#define H6(x_) __builtin_amdgcn_fmed3f((x_) * 2.0f, -7.5f, 7.5f)
        i32x8g hb[4];
#pragma unroll
        for (int t = 0; t < 4; ++t) { const size_t tok = (size_t)(tokb + t);
            unsigned a = ((unsigned)IDX[tok * 128 + lane] << 7) | (unsigned)lane, b = ((unsigned)IDX[tok * 128 + 64 + lane] << 7) | (unsigned)(64 + lane);
            sort128(a, b, lane); key0[t] = a; key1[t] = b;
            { f32x16t ea, eb;
#pragma unroll
              for (int c = 0; c < 2; ++c)
#pragma unroll
                for (int h = 0; h < 2; ++h) { const v4u w = *(const GAS v4u*)(H1B + tok * D + c * 1024 + lane * 16 + h * 8); const int q = 8 * c + 4 * h;
                    ea[q + 0] = H6(bf_lo_(w.x)); eb[q + 0] = H6(bf_hi_(w.x)); ea[q + 1] = H6(bf_lo_(w.y)); eb[q + 1] = H6(bf_hi_(w.y)); ea[q + 2] = H6(bf_lo_(w.z)); eb[q + 2] = H6(bf_hi_(w.z)); ea[q + 3] = H6(bf_lo_(w.w)); eb[q + 3] = H6(bf_hi_(w.w)); }
              const u32x6t w6 = __builtin_amdgcn_cvt_scalef32_2xpk16_fp6_f32(ea, eb, 1.0f);
              hb[t] = (i32x8g){(int)w6[0], (int)w6[1], (int)w6[2], (int)w6[3], (int)w6[4], (int)w6[5], 0, 0}; } }
        const bool dg = ((lane & 15) >> 2) == (lane >> 4);
        float dm0 = (dg && (lane & 3) == 0) ? 1.f : 0.f, dm1 = (dg && (lane & 3) == 1) ? 1.f : 0.f, dm2 = (dg && (lane & 3) == 2) ? 1.f : 0.f, dm3 = (dg && (lane & 3) == 3) ? 1.f : 0.f;
        asm volatile("" : "+v"(dm0), "+v"(dm1), "+v"(dm2), "+v"(dm3));
#define SROW_E(sg_, e_) do { const int sgc_ = (sg_) > 511 ? 511 : (sg_); const int pos_ = sgc_ >> 2; const unsigned kk_ = (pos_ < 64) ? key0[(sg_) & 3] : key1[(sg_) & 3]; \
            e_ = (int)((unsigned)__builtin_amdgcn_readlane((int)kk_, pos_ & 63) >> 7); } while (0)
#if PEER_U_FP4
#define UROW_DMA(sg_, slot_) do { int e_; SROW_E(sg_, e_); glds16(UB + (size_t)e_ * 1024 + lane16, ring + (unsigned)((slot_) * 2048)); } while (0)
#define U_WAIT() asm volatile("s_waitcnt vmcnt(6)" ::: "memory")
#define U_DECODE(up_, r0_, r1_) do { _Pragma("unroll") for (int d_ = 0; d_ < 4; ++d_) { \
        up_[4 * d_ + 0] = __builtin_bit_cast(unsigned, __builtin_amdgcn_cvt_scalef32_pk_bf16_fp4(r0_[d_], 1.0f, 0)); up_[4 * d_ + 1] = __builtin_bit_cast(unsigned, __builtin_amdgcn_cvt_scalef32_pk_bf16_fp4(r0_[d_], 1.0f, 1)); \
        up_[4 * d_ + 2] = __builtin_bit_cast(unsigned, __builtin_amdgcn_cvt_scalef32_pk_bf16_fp4(r0_[d_], 1.0f, 2)); up_[4 * d_ + 3] = __builtin_bit_cast(unsigned, __builtin_amdgcn_cvt_scalef32_pk_bf16_fp4(r0_[d_], 1.0f, 3)); } } while (0)
#else
#define UROW_DMA(sg_, slot_) do { int e_; SROW_E(sg_, e_); const unsigned char* src_ = UB + (size_t)e_ * 1536 + lane12; const unsigned dst_ = ring + (unsigned)((slot_) * 2048); glds12(src_, dst_); glds12(src_ + 768, dst_ + 1024u); } while (0)
#define U_WAIT() asm volatile("s_waitcnt vmcnt(12)" ::: "memory")
#define U_DECODE(up_, r0_, r1_) do { const u32x6t w6 = {r0_.x, r0_.y, r0_.z, r1_.x, r1_.y, r1_.z}; up_ = __builtin_bit_cast(u32x16t, __builtin_amdgcn_cvt_scalef32_pk32_bf16_fp6(w6, 1.0f)); } while (0)
#endif
#define VROW_DMA(sg_, slot_) do { int e_; SROW_E(sg_, e_); glds16(VT + (size_t)e_ * 1024 + lane16, ring + (unsigned)((slot_) * 2048)); } while (0)
        asm volatile("s_waitcnt vmcnt(0)" ::: "memory");
#if !PEER_U_FP4
        u32x6t ur[8];
#define UROW_LD(sg_, slot_) do { int e_; SROW_E(sg_, e_); const u32x3t a_ = __builtin_amdgcn_raw_buffer_load_b96(URS, (int)lane12, e_ * 1536, 0), b_ = __builtin_amdgcn_raw_buffer_load_b96(URS, (int)lane12 + 768, e_ * 1536, 0); \
            ur[slot_] = (u32x6t){a_.x, a_.y, a_.z, b_.x, b_.y, b_.z}; } while (0)
        UROW_LD(0, 0); UROW_LD(1, 1); UROW_LD(2, 2); UROW_LD(3, 3); UROW_LD(4, 4); UROW_LD(5, 5);
#else
        UROW_DMA(0, 0); UROW_DMA(1, 1); UROW_DMA(2, 2); UROW_DMA(3, 3); UROW_DMA(4, 4); UROW_DMA(5, 5);
#endif
        for (int blk = 0; blk < 8; ++blk) {
            float part[16];
#if !PEER_U_FP4
#define U_FETCH(s) UROW_LD(blk * 64 + (s) + 6, ((s) + 6) & 7);
#else
#define U_FETCH(s) UROW_DMA(blk * 64 + (s) + 6, ((s) + 6) & 7); U_WAIT(); const v4u r0 = rd[((s) & 7) * 128], r1 = rd[((s) & 7) * 128 + 64]; asm volatile("s_waitcnt lgkmcnt(0)" ::: "memory");
#endif
#define USTEP(s) do { U_FETCH(s) \
                const u32x6t w6_ = ur[(s) & 7]; const i32x8g A_ = {(int)w6_[0], (int)w6_[1], (int)w6_[2], (int)w6_[3], (int)w6_[4], (int)w6_[5], 0, 0}; \
                const f32x4 d_ = __builtin_amdgcn_mfma_scale_f32_16x16x128_f8f6f4(A_, hb[(s) & 3], (f32x4){0.f, 0.f, 0.f, 0.f}, 2, 2, 0, 0x7f7f7f7f, 0, 0x7f7f7f7f); \
                part[(s) & 15] = __builtin_fmaf(d_.w, dm3, __builtin_fmaf(d_.z, dm2, __builtin_fmaf(d_.y, dm1, d_.x * dm0))); \
                if (((s) & 15) == 15) { \
                    _Pragma("unroll") for (int st = 8; st >= 1; st >>= 1) { const bool up_ = (lane & st) != 0; \
                        _Pragma("unroll") for (int i = 0; i < st; ++i) { const float send = up_ ? part[i] : part[i + st], keep = up_ ? part[i + st] : part[i]; part[i] = keep + __shfl_xor(send, st); } } \
                    float tot = part[0]; tot += __shfl_xor(tot, 16); tot += __shfl_xor(tot, 32); \
                    if (lane < 16) AW[(lane & 3) * 128 + blk * 16 + (((s) - 15) >> 2) + (lane >> 2)] = tot; } \
            } while (0)
            USTEP(0); USTEP(1); USTEP(2); USTEP(3); USTEP(4); USTEP(5); USTEP(6); USTEP(7); USTEP(8); USTEP(9); USTEP(10); USTEP(11); USTEP(12); USTEP(13); USTEP(14); USTEP(15);
            USTEP(16); USTEP(17); USTEP(18); USTEP(19); USTEP(20); USTEP(21); USTEP(22); USTEP(23); USTEP(24); USTEP(25); USTEP(26); USTEP(27); USTEP(28); USTEP(29); USTEP(30); USTEP(31);
            USTEP(32); USTEP(33); USTEP(34); USTEP(35); USTEP(36); USTEP(37); USTEP(38); USTEP(39); USTEP(40); USTEP(41); USTEP(42); USTEP(43); USTEP(44); USTEP(45); USTEP(46); USTEP(47);
            USTEP(48); USTEP(49); USTEP(50); USTEP(51); USTEP(52); USTEP(53); USTEP(54); USTEP(55); USTEP(56); USTEP(57); USTEP(58); USTEP(59); USTEP(60); USTEP(61); USTEP(62); USTEP(63);
#undef USTEP
#undef U_FETCH
        }
        asm volatile("s_waitcnt vmcnt(0) lgkmcnt(0)" ::: "memory");
#pragma unroll
        for (int t = 0; t < 4; ++t) { const size_t tok = (size_t)(tokb + t);
            const float ga = GATE[tok * 128 + (key0[t] & 127u)], gb = GATE[tok * 128 + (key1[t] & 127u)];
            const float aa = AW[t * 128 + lane], ab = AW[t * 128 + 64 + lane];
            const _Float16 wa = (_Float16)(ga * gelu_erf(aa * (1.0f / (PEER_U_SCALE * 2.0f))) * (1.0f / 5.7f)), wb = (_Float16)(gb * gelu_erf(ab * (1.0f / (PEER_U_SCALE * 2.0f))) * (1.0f / 5.7f));
            AW[t * 128 + lane] = __builtin_bit_cast(float, (f16x2g){wa, wa}); AW[t * 128 + 64 + lane] = __builtin_bit_cast(float, (f16x2g){wb, wb}); }
        asm volatile("s_waitcnt vmcnt(0) lgkmcnt(0)" ::: "memory");
        f16x2g acc2[4][16];
#pragma unroll
        for (int t = 0; t < 4; ++t)
#pragma unroll
            for (int i = 0; i < 16; ++i) acc2[t][i] = (f16x2g){(_Float16)0.f, (_Float16)0.f};
        v4u vr[8];
#define VROW_LD(sg_, slot_) do { int e_; SROW_E(sg_, e_); vr[slot_] = *(const GAS v4u*)(VT + (size_t)e_ * 1024 + lane16); } while (0)
        VROW_LD(0, 0); VROW_LD(1, 1); VROW_LD(2, 2); VROW_LD(3, 3); VROW_LD(4, 4); VROW_LD(5, 5); VROW_LD(6, 6);
        for (int blk = 0; blk < 8; ++blk) {
#define FP4_BYTE(d_, b_) do { fp[4 * (d_) + (b_)] = __builtin_amdgcn_cvt_scalef32_pk_f16_fp4(r0[d_], 1.0f, b_); } while (0)
#define VSTEP(s) do { VROW_LD(blk * 64 + (s) + 7, ((s) + 7) & 7); \
                const v4u r0 = vr[(s) & 7]; const float wk = AW[((s) & 3) * 128 + blk * 16 + ((s) >> 2)]; \
                f16x2g fp[16]; const f16x2g wk2 = __builtin_bit_cast(f16x2g, wk); \
                _Pragma("unroll") for (int d = 0; d < 4; ++d) { FP4_BYTE(d, 0); FP4_BYTE(d, 1); FP4_BYTE(d, 2); FP4_BYTE(d, 3); } \
                _Pragma("unroll") for (int i = 0; i < 16; ++i) acc2[(s) & 3][i] = __builtin_elementwise_fma(fp[i], wk2, acc2[(s) & 3][i]); \
                _Pragma("unroll") for (int c = 0; c < 4; ++c) asm volatile("" : "+v"(acc2[(s) & 3][c * 4 + 0]), "+v"(acc2[(s) & 3][c * 4 + 1]), "+v"(acc2[(s) & 3][c * 4 + 2]), "+v"(acc2[(s) & 3][c * 4 + 3])); \
            } while (0)
            VSTEP(0); VSTEP(1); VSTEP(2); VSTEP(3); VSTEP(4); VSTEP(5); VSTEP(6); VSTEP(7); VSTEP(8); VSTEP(9); VSTEP(10); VSTEP(11); VSTEP(12); VSTEP(13); VSTEP(14); VSTEP(15);
            VSTEP(16); VSTEP(17); VSTEP(18); VSTEP(19); VSTEP(20); VSTEP(21); VSTEP(22); VSTEP(23); VSTEP(24); VSTEP(25); VSTEP(26); VSTEP(27); VSTEP(28); VSTEP(29); VSTEP(30); VSTEP(31);
            VSTEP(32); VSTEP(33); VSTEP(34); VSTEP(35); VSTEP(36); VSTEP(37); VSTEP(38); VSTEP(39); VSTEP(40); VSTEP(41); VSTEP(42); VSTEP(43); VSTEP(44); VSTEP(45); VSTEP(46); VSTEP(47);
            VSTEP(48); VSTEP(49); VSTEP(50); VSTEP(51); VSTEP(52); VSTEP(53); VSTEP(54); VSTEP(55); VSTEP(56); VSTEP(57); VSTEP(58); VSTEP(59); VSTEP(60); VSTEP(61); VSTEP(62); VSTEP(63);
#undef VSTEP
#undef FP4_BYTE
#undef VROW_LD
        }
#undef SROW_E
#undef UROW_DMA
#undef U_WAIT
#undef U_DECODE
#undef VROW_DMA
        asm volatile("s_waitcnt vmcnt(0) lgkmcnt(0)" ::: "memory");
#pragma unroll
        for (int t = 0; t < 4; ++t) { const size_t tok = (size_t)(tokb + t);
            float accv[32];
#pragma unroll
            for (int i = 0; i < 16; ++i) { accv[2 * i] = (float)acc2[t][i].x; accv[2 * i + 1] = (float)acc2[t][i].y; }
            float s = 0.f;
#pragma unroll
            for (int c = 0; c < 2; ++c) { const size_t off = tok * D + c * 1024 + lane * 16;
#pragma unroll
                for (int h = 0; h < 2; ++h) { const v4u pv = *(const GAS v4u*)(PLE + off + h * 8), hv = *(const GAS v4u*)(H1B + off + h * 8); const int b0 = c * 16 + h * 8;
                    accv[b0 + 0] += DN_ALPHA * bf_lo_(hv.x) + bf_lo_(pv.x); accv[b0 + 1] += DN_ALPHA * bf_hi_(hv.x) + bf_hi_(pv.x); accv[b0 + 2] += DN_ALPHA * bf_lo_(hv.y) + bf_lo_(pv.y); accv[b0 + 3] += DN_ALPHA * bf_hi_(hv.y) + bf_hi_(pv.y);
                    accv[b0 + 4] += DN_ALPHA * bf_lo_(hv.z) + bf_lo_(pv.z); accv[b0 + 5] += DN_ALPHA * bf_hi_(hv.z) + bf_hi_(pv.z); accv[b0 + 6] += DN_ALPHA * bf_lo_(hv.w) + bf_lo_(pv.w); accv[b0 + 7] += DN_ALPHA * bf_hi_(hv.w) + bf_hi_(pv.w); } }
#pragma unroll
            for (int i = 0; i < 32; ++i) s += accv[i];
            const float mean = wave_sum(s) * (1.f / D); float s2 = 0.f;
#pragma unroll
            for (int i = 0; i < 32; ++i) { accv[i] -= mean; s2 += accv[i] * accv[i]; }
            const float rstd = 1.f / sqrtf(wave_sum(s2) * (1.f / D) + LN_EPS);
#pragma unroll
            for (int c = 0; c < 2; ++c)
#pragma unroll
                for (int j = 0; j < 4; ++j) { const int col = c * 1024 + lane * 16 + j * 4; const size_t off = tok * D + col; const int b0 = c * 16 + j * 4;
                    const f32x4 ga = *(const GAS f32x4*)(ln2_g + col), ba = *(const GAS f32x4*)(ln2_b + col);
                    f32x4 o0; o0.x = accv[b0 + 0] * rstd * ga.x + ba.x; o0.y = accv[b0 + 1] * rstd * ga.y + ba.y; o0.z = accv[b0 + 2] * rstd * ga.z + ba.z; o0.w = accv[b0 + 3] * rstd * ga.w + ba.w;
                    *(GAS f32x4*)(out + off) = o0; } }
    }
}
template <int R, int KLO = 2, int KHI = 64 * R> __device__ __forceinline__ void sort_wave(unsigned (&k)[R], int lane) {
#pragma unroll
    for (int kk = KLO; kk <= KHI; kk <<= 1)
#pragma unroll
        for (int j = kk >> 1; j > 0; j >>= 1) {
            if (j >= 64) { const int jr = j >> 6;
#pragma unroll
                for (int r = 0; r < R; ++r) if ((r & jr) == 0) { const bool asc = (kk == 64 * R) ? true : ((r & (kk >> 6)) == 0);
                    const unsigned x = k[r], y = k[r | jr], mn = x < y ? x : y, mx = x < y ? y : x; k[r] = asc ? mn : mx; k[r | jr] = asc ? mx : mn; }
            } else {
#pragma unroll
                for (int r = 0; r < R; ++r) { const unsigned pq = (unsigned)__shfl_xor((int)k[r], j); const bool lower = (lane & j) == 0;
                    const bool asc = (kk == 64 * R) ? true : ((kk >= 64) ? ((r & (kk >> 6)) == 0) : ((lane & kk) == 0));
                    const unsigned mn = k[r] < pq ? k[r] : pq, mx = k[r] < pq ? pq : k[r]; k[r] = (lower == asc) ? mn : mx; }
            }
        }
}
__device__ __forceinline__ void p10_gather_sorted8(Frame& F, const float* ln2_g, const float* ln2_b, float* out) {
    constexpr int NT = 8;
    const bf16* H1B = (const bf16*)(F.ws + WS_H1B); const bf16* PLE = (const bf16*)(F.ws + WS_PP);
    const unsigned char* UB = (const unsigned char*)(F.ws + WS_UB); const unsigned char* VT = (const unsigned char*)(F.ws + WS_VT);
    const int* IDX = (const int*)(F.ws + WS_IDX); const float* GATE = (const float*)(F.ws + WS_GATE);
    const int tokb = (F.vcu * NWAVES + F.wave) * NT;
    const __amdgpu_buffer_rsrc_t URS = __builtin_amdgcn_make_buffer_rsrc((void*)UB, 0, 0x7fffffff, 0x00020000);
    LAS float* AW = (LAS float*)(F.lds + RING_OFF + F.wave * 16384);
    int lane = lane_(); asm volatile("" : "+v"(lane));
    const unsigned lane12 = (unsigned)lane * 12u, lane16 = (unsigned)lane * 16u;
    unsigned key0[NT], key1[NT];
    unsigned mk[16];
    LAS unsigned char* hbL = F.lds + RING_OFF + F.wave * 16384 + 4096;
#pragma unroll
    for (int t = 0; t < NT; ++t) { const size_t tok = (size_t)(tokb + t);
        const unsigned xa = (unsigned)IDX[tok * 128 + lane], xb = (unsigned)IDX[tok * 128 + 64 + lane];
        mk[2 * t] = (xa << 10) | (unsigned)(t << 7) | (unsigned)lane; mk[2 * t + 1] = (xb << 10) | (unsigned)(t << 7) | (unsigned)(64 + lane);
        f32x16t ea, eb;
#pragma unroll
        for (int c = 0; c < 2; ++c)
#pragma unroll
            for (int h = 0; h < 2; ++h) { const v4u w = *(const GAS v4u*)(H1B + tok * D + c * 1024 + lane * 16 + h * 8); const int q = 8 * c + 4 * h;
                ea[q + 0] = H6S(bf_lo_(w.x)); eb[q + 0] = H6S(bf_hi_(w.x)); ea[q + 1] = H6S(bf_lo_(w.y)); eb[q + 1] = H6S(bf_hi_(w.y)); ea[q + 2] = H6S(bf_lo_(w.z)); eb[q + 2] = H6S(bf_hi_(w.z)); ea[q + 3] = H6S(bf_lo_(w.w)); eb[q + 3] = H6S(bf_hi_(w.w)); }
        const u32x6t h6 = __builtin_amdgcn_cvt_scalef32_2xpk16_fp6_f32(ea, eb, 1.0f);
        *(LAS v4u*)(hbL + t * 1536 + lane * 16) = (v4u){h6[0], h6[1], h6[2], h6[3]}; *(LAS u32x2v*)(hbL + t * 1536 + 1024 + lane * 8) = (u32x2v){h6[4], h6[5]}; }
    sort_wave<16, 2, 128>(mk, lane);
#pragma unroll
    for (int t = 0; t < NT; ++t) {
        const unsigned a = ((mk[2 * t] >> 10) << 7) | (mk[2 * t] & 127u), b = ((mk[2 * t + 1] >> 10) << 7) | (mk[2 * t + 1] & 127u);
        if ((t & 1) == 0) { key0[t] = a; key1[t] = b; } else { key0[t] = (unsigned)__shfl((int)b, 63 - lane); key1[t] = (unsigned)__shfl((int)a, 63 - lane); } }
    sort_wave<16, 256, 1024>(mk, lane);
    const bool dg = ((lane & 15) >> 2) == (lane >> 4);
    float dm0 = (dg && (lane & 3) == 0) ? 1.f : 0.f, dm1 = (dg && (lane & 3) == 1) ? 1.f : 0.f, dm2 = (dg && (lane & 3) == 2) ? 1.f : 0.f, dm3 = (dg && (lane & 3) == 3) ? 1.f : 0.f;
    asm volatile("" : "+v"(dm0), "+v"(dm1), "+v"(dm2), "+v"(dm3));
#define SROW_E(sg_, e_) do { const int sgc_ = (sg_) > 1023 ? 1023 : (sg_); const int pos_ = sgc_ >> 3; const unsigned kk_ = (pos_ < 64) ? key0[(sg_) & 7] : key1[(sg_) & 7]; \
        e_ = (int)((unsigned)__builtin_amdgcn_readlane((int)kk_, pos_ & 63) >> 7); } while (0)
#define SROW_S(sg_, sl_) do { const int pos_ = (sg_) >> 3; const unsigned kk_ = (pos_ < 64) ? key0[(sg_) & 7] : key1[(sg_) & 7]; sl_ = (int)((unsigned)__builtin_amdgcn_readlane((int)kk_, pos_ & 63) & 127u); } while (0)
    asm volatile("s_waitcnt vmcnt(0) lgkmcnt(0)" ::: "memory");
    { u32x6t ur[8];
#define MKEY(sg_) ((unsigned)(((sg_) < 64) ? __builtin_amdgcn_readlane((int)mk[0], (sg_) & 63) : __builtin_amdgcn_readlane((int)mk[1], ((sg_) - 64) & 63)))
#define UROW_LD(sg_, slot_) do { const int e_ = (int)(MKEY(sg_) >> 10); const u32x3t a_ = __builtin_amdgcn_raw_buffer_load_b96(URS, (int)lane12, e_ * 1536, 0), b_ = __builtin_amdgcn_raw_buffer_load_b96(URS, (int)lane12 + 768, e_ * 1536, 0); \
        ur[slot_] = (u32x6t){a_.x, a_.y, a_.z, b_.x, b_.y, b_.z}; } while (0)
      UROW_LD(0, 0); UROW_LD(1, 1); UROW_LD(2, 2); UROW_LD(3, 3); UROW_LD(4, 4); UROW_LD(5, 5);
      for (int blk = 0; blk < 16; ++blk) {
        float part[16];
#define USTEP(s) do { UROW_LD((s) + 6, ((s) + 6) & 7); \
            const LAS unsigned char* hp_ = hbL + ((MKEY(s) >> 7) & 7u) * 1536u; const v4u ha_ = *(const LAS v4u*)(hp_ + lane * 16); const u32x2v hc_ = *(const LAS u32x2v*)(hp_ + 1024 + lane * 8); \
            const u32x6t w6_ = ur[(s) & 7]; const i32x8g A_ = {(int)w6_[0], (int)w6_[1], (int)w6_[2], (int)w6_[3], (int)w6_[4], (int)w6_[5], 0, 0}, B_ = {(int)ha_.x, (int)ha_.y, (int)ha_.z, (int)ha_.w, (int)hc_.x, (int)hc_.y, 0, 0}; \
            const f32x4 d_ = __builtin_amdgcn_mfma_scale_f32_16x16x128_f8f6f4(A_, B_, (f32x4){0.f, 0.f, 0.f, 0.f}, 2, 2, 0, 0x7f7f7f7f, 0, 0x7f7f7f7f); \
            part[(s) & 15] = __builtin_fmaf(d_.w, dm3, __builtin_fmaf(d_.z, dm2, __builtin_fmaf(d_.y, dm1, d_.x * dm0))); \
            if (((s) & 15) == 15) { \
                _Pragma("unroll") for (int st = 8; st >= 1; st >>= 1) { const bool up_ = (lane & st) != 0; \
                    _Pragma("unroll") for (int i = 0; i < st; ++i) { const float send = up_ ? part[i] : part[i + st], keep = up_ ? part[i + st] : part[i]; part[i] = keep + __shfl_xor(send, st); } } \
                float tot = part[0]; tot += __shfl_xor(tot, 16); tot += __shfl_xor(tot, 32); \
                if (lane < 16) AW[blk * 64 + ((s) - 15) + lane] = tot; } \
        } while (0)
        USTEP(0); USTEP(1); USTEP(2); USTEP(3); USTEP(4); USTEP(5); USTEP(6); USTEP(7); USTEP(8); USTEP(9); USTEP(10); USTEP(11); USTEP(12); USTEP(13); USTEP(14); USTEP(15);
        USTEP(16); USTEP(17); USTEP(18); USTEP(19); USTEP(20); USTEP(21); USTEP(22); USTEP(23); USTEP(24); USTEP(25); USTEP(26); USTEP(27); USTEP(28); USTEP(29); USTEP(30); USTEP(31);
        USTEP(32); USTEP(33); USTEP(34); USTEP(35); USTEP(36); USTEP(37); USTEP(38); USTEP(39); USTEP(40); USTEP(41); USTEP(42); USTEP(43); USTEP(44); USTEP(45); USTEP(46); USTEP(47);
        USTEP(48); USTEP(49); USTEP(50); USTEP(51); USTEP(52); USTEP(53); USTEP(54); USTEP(55); USTEP(56); USTEP(57); USTEP(58); USTEP(59); USTEP(60); USTEP(61); USTEP(62); USTEP(63);
#undef USTEP
        { const unsigned m0_ = mk[0];
#pragma unroll
          for (int r = 0; r < 15; ++r) mk[r] = mk[r + 1];
          mk[15] = m0_; }
      }
#undef UROW_LD
#undef MKEY
    }
    asm volatile("s_waitcnt vmcnt(0) lgkmcnt(0)" ::: "memory");
    LAS float* W2 = (LAS float*)hbL;
#pragma unroll
    for (int r = 0; r < 16; ++r) { const unsigned ts = mk[r] & 1023u; const float g = GATE[(size_t)tokb * 128 + ts]; const float a = AW[r * 64 + lane];
        const _Float16 wv = (_Float16)(g * gelu_erf(a * (1.0f / (PEER_U_SCALE * 2.0f))) * (1.0f / 5.7f)); W2[ts] = __builtin_bit_cast(float, (f16x2g){wv, wv});
        asm volatile("" ::: "memory"); }
    asm volatile("s_waitcnt lgkmcnt(0)" ::: "memory");
#pragma unroll
    for (int t = 0; t < NT; ++t) { const float wa = W2[t * 128 + (key0[t] & 127u)], wb = W2[t * 128 + (key1[t] & 127u)]; AW[t * 128 + lane] = wa; AW[t * 128 + 64 + lane] = wb; }
    asm volatile("s_waitcnt vmcnt(0) lgkmcnt(0)" ::: "memory");
    f16x2g acc2[NT][16];
#pragma unroll
    for (int t = 0; t < NT; ++t)
#pragma unroll
        for (int i = 0; i < 16; ++i) acc2[t][i] = (f16x2g){(_Float16)0.f, (_Float16)0.f};
    { v4u vr[4];
#define VROW_LD(sg_, slot_) do { int e_; SROW_E(sg_, e_); vr[slot_] = *(const GAS v4u*)(VT + (size_t)e_ * 1024 + lane16); } while (0)
      VROW_LD(0, 0); VROW_LD(1, 1); VROW_LD(2, 2);
      for (int blk = 0; blk < 16; ++blk) {
#define FP4_BYTE(d_, b_) do { fp[4 * (d_) + (b_)] = __builtin_amdgcn_cvt_scalef32_pk_f16_fp4(r0[d_], 1.0f, b_); } while (0)
#define VSTEP(s) do { VROW_LD(blk * 64 + (s) + 3, ((s) + 3) & 3); \
            const v4u r0 = vr[(s) & 3]; const float wk = AW[((s) & 7) * 128 + blk * 8 + ((s) >> 3)]; \
            f16x2g fp[16]; const f16x2g wk2 = __builtin_bit_cast(f16x2g, wk); \
            _Pragma("unroll") for (int d = 0; d < 4; ++d) { FP4_BYTE(d, 0); FP4_BYTE(d, 1); FP4_BYTE(d, 2); FP4_BYTE(d, 3); } \
            _Pragma("unroll") for (int i = 0; i < 16; ++i) acc2[(s) & 7][i] = __builtin_elementwise_fma(fp[i], wk2, acc2[(s) & 7][i]); \
            _Pragma("unroll") for (int c = 0; c < 4; ++c) asm volatile("" : "+v"(acc2[(s) & 7][c * 4 + 0]), "+v"(acc2[(s) & 7][c * 4 + 1]), "+v"(acc2[(s) & 7][c * 4 + 2]), "+v"(acc2[(s) & 7][c * 4 + 3])); \
        } while (0)
        VSTEP(0); VSTEP(1); VSTEP(2); VSTEP(3); VSTEP(4); VSTEP(5); VSTEP(6); VSTEP(7); VSTEP(8); VSTEP(9); VSTEP(10); VSTEP(11); VSTEP(12); VSTEP(13); VSTEP(14); VSTEP(15);
        VSTEP(16); VSTEP(17); VSTEP(18); VSTEP(19); VSTEP(20); VSTEP(21); VSTEP(22); VSTEP(23); VSTEP(24); VSTEP(25); VSTEP(26); VSTEP(27); VSTEP(28); VSTEP(29); VSTEP(30); VSTEP(31);
        VSTEP(32); VSTEP(33); VSTEP(34); VSTEP(35); VSTEP(36); VSTEP(37); VSTEP(38); VSTEP(39); VSTEP(40); VSTEP(41); VSTEP(42); VSTEP(43); VSTEP(44); VSTEP(45); VSTEP(46); VSTEP(47);
        VSTEP(48); VSTEP(49); VSTEP(50); VSTEP(51); VSTEP(52); VSTEP(53); VSTEP(54); VSTEP(55); VSTEP(56); VSTEP(57); VSTEP(58); VSTEP(59); VSTEP(60); VSTEP(61); VSTEP(62); VSTEP(63);
#undef VSTEP
#undef FP4_BYTE
#undef VROW_LD
      } }
#undef SROW_E
#undef SROW_S
    asm volatile("s_waitcnt vmcnt(0) lgkmcnt(0)" ::: "memory");
    int lt = lane_(); asm volatile("" : "+v"(lt));
#pragma unroll
    for (int t = 0; t < NT; ++t) { const size_t tok = (size_t)(tokb + t);
        float accv[32];
#pragma unroll
        for (int i = 0; i < 16; ++i) { accv[2 * i] = (float)acc2[t][i].x; accv[2 * i + 1] = (float)acc2[t][i].y; }
        float s = 0.f;
#pragma unroll
        for (int c = 0; c < 2; ++c) { const size_t off = tok * D + c * 1024 + lt * 16;
#pragma unroll
            for (int h = 0; h < 2; ++h) { const v4u pv = *(const GAS v4u*)(PLE + off + h * 8), hv = *(const GAS v4u*)(H1B + off + h * 8); const int b0 = c * 16 + h * 8;
                accv[b0 + 0] += DN_ALPHA * bf_lo_(hv.x) + bf_lo_(pv.x); accv[b0 + 1] += DN_ALPHA * bf_hi_(hv.x) + bf_hi_(pv.x); accv[b0 + 2] += DN_ALPHA * bf_lo_(hv.y) + bf_lo_(pv.y); accv[b0 + 3] += DN_ALPHA * bf_hi_(hv.y) + bf_hi_(pv.y);
                accv[b0 + 4] += DN_ALPHA * bf_lo_(hv.z) + bf_lo_(pv.z); accv[b0 + 5] += DN_ALPHA * bf_hi_(hv.z) + bf_hi_(pv.z); accv[b0 + 6] += DN_ALPHA * bf_lo_(hv.w) + bf_lo_(pv.w); accv[b0 + 7] += DN_ALPHA * bf_hi_(hv.w) + bf_hi_(pv.w); } }
#pragma unroll
        for (int i = 0; i < 32; ++i) s += accv[i];
        const float mean = wave_sum(s) * (1.f / D); float s2 = 0.f;
#pragma unroll
        for (int i = 0; i < 32; ++i) { accv[i] -= mean; s2 += accv[i] * accv[i]; }
        const float rstd = 1.f / sqrtf(wave_sum(s2) * (1.f / D) + LN_EPS);
#pragma unroll
        for (int c = 0; c < 2; ++c)
#pragma unroll
            for (int j = 0; j < 4; ++j) { const int col = c * 1024 + lt * 16 + j * 4; const size_t off = tok * D + col; const int b0 = c * 16 + j * 4;
                const f32x4 ga = *(const GAS f32x4*)(ln2_g + col), ba = *(const GAS f32x4*)(ln2_b + col);
                f32x4 o0; o0.x = accv[b0 + 0] * rstd * ga.x + ba.x; o0.y = accv[b0 + 1] * rstd * ga.y + ba.y; o0.z = accv[b0 + 2] * rstd * ga.z + ba.z; o0.w = accv[b0 + 3] * rstd * ga.w + ba.w;
                *(GAS f32x4*)(out + off) = o0; } }
}
struct Args { const float* in[17]; float* out; unsigned char* ws; int ph_lo, ph_hi, li, pad; };
template <int BYTE_OFF> __device__ __forceinline__ const float* karg_ptr() {
    auto kp = __builtin_amdgcn_kernarg_segment_ptr(); unsigned long long v;
    asm volatile("s_load_dwordx2 %0, %1, %2\n\ts_waitcnt lgkmcnt(0)" : "=s"(v) : "s"(kp), "i"(BYTE_OFF) : "memory");
    return (const float*)v;
}
#define KIN(k) karg_ptr<8 * (k)>()
__global__ void __launch_bounds__(NWAVES * 64, 2) mk_fwd(Args args) {
    extern __shared__ __attribute__((aligned(16))) unsigned char lds[];
    Frame F;
    F.lds = (LAS unsigned char*)lds;
    F.MISC = (volatile LAS unsigned*)(F.lds + MISC_OFF);
    F.wave = __builtin_amdgcn_readfirstlane((int)(threadIdx.x >> 6));
    F.G = gridDim.x; { const int bx = blockIdx.x; F.vcu = (F.G % 8 == 0) ? (bx % 8) * (F.G / 8) + bx / 8 : bx; }
    unsigned char* ws = args.ws; F.ws = ws;
    F.ctl = (gu32*)(ws + WS_CTL);
    for (int u = tid_(); u < (LDS_BYTES - LDSCTL_OFF) / 4; u += NWAVES * 64) ((LAS unsigned*)(F.lds + LDSCTL_OFF))[u] = 0u;
    __syncthreads();
    XcdBarrier bar; bar.bar = (unsigned*)(F.ctl + CW_BAR); bar.x = 0; bar.st = nullptr;
    if (N_LAUNCHES == 1) bar = xcd_barrier_post((unsigned*)(F.ctl + CW_BAR), F.MISC + 8);
#define GRID_BAR() do { if (N_LAUNCHES == 1) xcd_barrier(bar); } while (0)
    const int lo = args.ph_lo, hi = args.ph_hi;
#define IN(k) (lo <= (k) && (k) < hi)
#ifndef DBL_MASK
#define DBL_MASK 0
#endif
#define REP(k) for (int rep_ = 0; rep_ <= ((DBL_MASK >> (k)) & 1); ++rep_)
#define BOTH(k) (IN(k) && IN((k) + 1))
    bf16* const WIN = (bf16*)(ws + WS_WIN); bf16* const XB = (bf16*)(ws + WS_XB); bf16* const G = (bf16*)(ws + WS_G);

    if (IN(0)) { REP(0) p0_prologue(F, KIN(0), KIN(1), KIN(2), KIN(4), KIN(5), KIN(6), KIN(9), KIN(10), KIN(13), KIN(14)); if (BOTH(0)) GRID_BAR(); }

    if (IN(1)) {
        pg8::Gemm g{XB, WIN, T, IN_COLS, D}; pg8::StaticOrder So; So.init(T, IN_COLS, F.G, (int)blockIdx.x, WGM_P1);
        pg8::EpiQKV E{(bf16*)(ws + WS_QA), (bf16*)(ws + WS_KA), (bf16*)(ws + WS_VA), (bf16*)(ws + WS_QB), (bf16*)(ws + WS_KB), (bf16*)(ws + WS_VB), G, (const float*)(ws + WS_COS), (const float*)(ws + WS_SIN), 1.0f / 32768.0f};
        pg8::gemm_phase8<pg8::EpiQKV, pg8::StaticOrder, false, true>(F.lds + RING_OFF, g, So, E);
        if (BOTH(1)) GRID_BAR();
    }
    if (IN(2)) { REP(2) p2_attention(F, KIN(3)); if (BOTH(2)) GRID_BAR(); }
    if (IN(3)) { REP(3) p3_combine(F, KIN(11), KIN(12)); if (BOTH(3)) GRID_BAR(); }
    if (IN(4)) {
        int kba = 512; asm volatile("" : "+s"(kba));
        pg8::Gemm g{(const bf16*)(ws + WS_OA), (const bf16*)(ws + WS_WBA), T, D, kba}; pg8::StaticOrder So; So.init(T, D, F.G, (int)blockIdx.x, WGM_X);
        pg8::EpiBranchA E{G, 1.0f / 8192.0f};
        pg8::gemm_phase8<pg8::EpiBranchA, pg8::StaticOrder, true, true>(F.lds + RING_OFF, g, So, E);
    }
    if (IN(5)) {
        pg8::Gemm g{(const bf16*)(ws + WS_OB), (const bf16*)(ws + WS_WBB), T, D, 1024}; pg8::StaticOrder So; So.init(T, D, F.G, (int)blockIdx.x, WGM_X);
        pg8::EpiBranchB E{G, ws + WS_MERGED, 1.0f / 16384.0f};
        REP(5) pg8::gemm_phase8<pg8::EpiBranchB, pg8::StaticOrder, true, true>(F.lds + RING_OFF, g, So, E);
        if (BOTH(5)) GRID_BAR();
    }
    if (IN(6)) {
        pg8::Gemm g{(const bf16*)(ws + WS_MERGED), (const bf16*)(ws + WS_WOUT), T, D, D}; pg8::StaticOrder So; So.init(T, D, F.G, (int)blockIdx.x, WGM_X);
        pg8::EpiWout E{KIN(0), (bf16*)(ws + WS_H1), DN_ALPHA, 1.0f / 65536.0f};
        REP(6) pg8::gemm_phase8<pg8::EpiWout, pg8::StaticOrder, true, true>(F.lds + RING_OFF, g, So, E);
        if (BOTH(6)) GRID_BAR();
    }
    if (IN(7)) {
        p7_ln1(F, KIN(7), KIN(8));
        int kpp = 256; asm volatile("" : "+s"(kpp));
        pg8::Gemm g{(const bf16*)(ws + WS_PB), (const bf16*)(ws + WS_WPP), T, D, kpp}; pg8::StaticOrder So; So.init(T, D, F.G, (int)blockIdx.x, WGM_X);
        pg8::EpiPlain E{(bf16*)(ws + WS_PP), D};
        pg8::gemm_phase<pg8::EpiPlain, pg8::StaticOrder, true, true>(F.lds + RING_OFF, g, So, E);
        if (BOTH(7)) GRID_BAR();
    }
    if (IN(8)) {
        { pg8::Gemm g{(const bf16*)(ws + WS_H1B), (const bf16*)(ws + WS_WQG), T, D, D}; pg8::StaticOrder So; So.init(T, D, F.G, (int)blockIdx.x, WGM_X);
          pg8::EpiPlain E{(bf16*)(ws + WS_Q), D};
          pg8::gemm_phase<pg8::EpiPlain, pg8::StaticOrder, true, true>(F.lds + RING_OFF, g, So, E); }
        { pg8::Gemm g{(const bf16*)(ws + WS_H1F8), (const bf16*)(ws + WS_WQG + (size_t)8 * MiB), T, D, D}; pg8::StaticOrder So; So.init(T, D, F.G, (int)blockIdx.x, WGM_X);
          pg8::EpiPle E{(bf16*)(ws + WS_PP), 1.0f / 32768.0f};
          pg8::gemm_phase8<pg8::EpiPle, pg8::StaticOrder, true, true>(F.lds + RING_OFF, g, So, E); }
        if (BOTH(8)) GRID_BAR();
    }
    if (IN(9)) {
        REP(9) { if (F.wave < 4) { p9_route(F); if (PEER_U_FP4) cvt_copy_fp4(F, KIN(11), ws + WS_UB, 16384, PEER_U_SCALE); else cvt_copy_fp6(F, KIN(11), ws + WS_UB, 16384, PEER_U_SCALE); cvt_copy_fp4(F, KIN(12), ws + WS_VT, 16384, 5.7f); }
                 else { if (PEER_U_FP4) cvt_copy_fp4(F, KIN(11), ws + WS_UB, 16384, PEER_U_SCALE); else cvt_copy_fp6(F, KIN(11), ws + WS_UB, 16384, PEER_U_SCALE); cvt_copy_fp4(F, KIN(12), ws + WS_VT, 16384, 5.7f); p9_route(F); } }
        if (BOTH(9)) GRID_BAR(); }
    if (IN(10)) { if (T == F.G * NWAVES * 8) p10_gather_sorted8(F, KIN(15), KIN(16), (float*)KIN(17));
                  else if (((T / (F.G * NWAVES)) & 3) == 0 && (T % (F.G * NWAVES)) == 0) p10_gather_sorted(F, KIN(15), KIN(16), (float*)KIN(17)); else p10_gather(F, KIN(15), KIN(16), (float*)KIN(17)); }
#undef IN
#undef BOTH
}

extern "C" void kernel_launch(void* const* d_in, const int* in_sizes, int n_in, void* d_out, int out_size, void* d_ws, size_t ws_size, hipStream_t stream) {
    static int grid = 0;
    if (grid == 0) {
        if (n_in != 17 || in_sizes[0] != T * D || out_size != T * D || ws_size < WS_END) { fprintf(stderr, "kernel_launch: unexpected shapes (n_in %d, in0 %d, out %d, ws %zu); nothing launched\n", n_in, n_in > 0 ? in_sizes[0] : -1, out_size, ws_size); grid = -1; return; }
        int dev = 0, cus = 0, per_cu = 0;
        if (hipGetDevice(&dev) != hipSuccess || hipDeviceGetAttribute(&cus, hipDeviceAttributeMultiprocessorCount, dev) != hipSuccess) { grid = -1; return; }
        if (hipFuncSetAttribute((const void*)mk_fwd, hipFuncAttributeMaxDynamicSharedMemorySize, LDS_BYTES) != hipSuccess) { fprintf(stderr, "kernel_launch: hipFuncSetAttribute failed\n"); grid = -1; return; }
        if (hipOccupancyMaxActiveBlocksPerMultiprocessor(&per_cu, (const void*)mk_fwd, NWAVES * 64, LDS_BYTES) != hipSuccess || per_cu < 1)
            fprintf(stderr, "kernel_launch: note: occupancy query reports %d workgroups per CU\n", per_cu);
        (void)hipGetLastError();
        grid = cus;
    }
    if (grid < 0) return;
    if (N_LAUNCHES == 1) { if (hipMemsetAsync((char*)d_ws + WS_CTL, 0, CTL_ZERO_BYTES, stream) != hipSuccess) { fprintf(stderr, "kernel_launch: hipMemsetAsync failed\n"); return; } }
    Args a{};
    for (int i = 0; i < 17; ++i) a.in[i] = (const float*)d_in[i];
    a.out = (float*)d_out; a.ws = (unsigned char*)d_ws;
    for (int li = 0; li < N_LAUNCHES; ++li) {
        a.ph_lo = (N_LAUNCHES == 1) ? 0 : li; a.ph_hi = (N_LAUNCHES == 1) ? NPHASES : li + 1; a.li = li;
        hipLaunchKernelGGL(mk_fwd, dim3(grid), dim3(NWAVES * 64), LDS_BYTES, stream, a);
        const hipError_t le = hipPeekAtLastError();
        if (le != hipSuccess) { fprintf(stderr, "kernel_launch: launch %d failed: %s\n", li, hipGetErrorName(le)); break; }
    }
}
```
